# Optimizing an MI355X kernel written in HIP

```python
import math
import jax
import jax.numpy as jnp
from jax import lax
import numpy as np

D_MODEL = 1024
BATCH = 8
SEQ = 4096
DEPTH = 1

CTX_LEN = 256
GRID_W = 64
A_HEADS = 8
A_DH = 64
A_DV = 2 * A_DH
A_WIDTH = A_HEADS * A_DV
H_HEADS = 8
H_DK = 128
H_DV = 128
H_WIDTH = H_HEADS * H_DV
CHUNK = 64
Q_BLOCK = 128
ROPE_BASE = 10000.0
EPS = 1e-6

IN_COLS = (
    ("attn_k", A_HEADS * 2 * A_DH),
    ("attn_v", A_WIDTH),
    ("hgrn_i", H_WIDTH),
    ("hgrn_f_fwd", H_HEADS * H_DK),
    ("hgrn_f_bwd", H_HEADS * H_DK),
    ("attn_q", A_HEADS * 2 * A_DH),
    ("hgrn_q", H_HEADS * H_DK),
    ("attn_z", A_WIDTH),
    ("hgrn_z", H_WIDTH),
    ("merge_gate", 2 * D_MODEL),
)
IN_WIDTH = (4 * A_HEADS * A_DH + A_WIDTH + H_WIDTH + 3 * H_HEADS * H_DK
            + A_WIDTH + H_WIDTH + 2 * D_MODEL)

kernel_name = "hybrid_diffattn_hgrn2_dit_layer"


def _rms(u, gain):
    uf = u.astype(jnp.float32)
    y = uf * lax.rsqrt(jnp.mean(uf * uf, axis=-1, keepdims=True) + EPS)
    return (y * gain.astype(jnp.float32)).astype(u.dtype)


def _cols(w, name):
    start = 0
    for n, width in IN_COLS:
        if n == name:
            return w[:, start:start + width]
        start += width
    raise KeyError(name)


def _axial_rope(n_tok):
    rows = n_tok // GRID_W
    row = jnp.repeat(jnp.arange(rows, dtype=jnp.float32), GRID_W)
    col = jnp.tile(jnp.arange(GRID_W, dtype=jnp.float32), rows)
    half = A_DH // 2
    inv = ROPE_BASE ** (-jnp.arange(0, half, 2, dtype=jnp.float32) / half)
    ar = row[:, None] * inv[None, :]
    ac = col[:, None] * inv[None, :]
    ang = jnp.concatenate([ar, ar, ac, ac], axis=-1)
    return jnp.cos(ang), jnp.sin(ang)


def _rotate_half_axial(u):
    ur, uc = jnp.split(u, 2, axis=-1)
    r1, r2 = jnp.split(ur, 2, axis=-1)
    c1, c2 = jnp.split(uc, 2, axis=-1)
    return jnp.concatenate([-r2, r1, -c2, c1], axis=-1)


def _apply_rope(u, cos, sin):
    return (u * cos + _rotate_half_axial(u) * sin).astype(u.dtype)


def _qk_heads(p, gain):
    B, T, _ = p.shape
    u = _rms(p.reshape(B, T, A_HEADS, 2, A_DH), gain)
    return u.transpose(0, 2, 3, 1, 4)


def _v_heads(p):
    B, T, _ = p.shape
    return p.reshape(B, T, A_HEADS, A_DV).transpose(0, 2, 1, 3)


def _diff_attention(q, k, v, lam):
    B, H, _, T, dh = q.shape
    nb = T // Q_BLOCK
    qb = q.reshape(B, H, 2, nb, Q_BLOCK, dh).transpose(3, 0, 1, 2, 4, 5)

    def block(qblk):
        s = jnp.einsum("bhmqd,bhmkd->bhmqk", qblk, k).astype(jnp.float32)
        p = jax.nn.softmax(s, axis=-1)
        w = p[:, :, 0] - lam * p[:, :, 1]
        return jnp.einsum("bhqk,bhkd->bhqd", w.astype(v.dtype), v)

    o = lax.map(block, qb)
    return o.transpose(1, 0, 3, 2, 4).reshape(B, T, H, A_DV)


def _lower_bound(p, l):
    return jnp.cumsum(jax.nn.softmax(p.astype(jnp.float32), axis=0), axis=0)[l]


def _log_forget(a, lb):
    B, T, _ = a.shape
    f = lb + (1.0 - lb) * jax.nn.sigmoid(a.astype(jnp.float32))
    return jnp.log(f).reshape(B, T, H_HEADS, H_DK)


def _hgrn2_scan(q, log_f, v, s0):
    B, T, H, _ = log_f.shape
    n = T // CHUNK

    def chunks(u):
        return u.astype(jnp.float32).reshape(B, n, CHUNK, H, u.shape[-1]).transpose(1, 0, 3, 2, 4)

    k = -jnp.expm1(log_f.astype(jnp.float32))
    xs = (chunks(log_f), chunks(k), chunks(v))
    if q is not None:
        xs = xs + (chunks(q),)
    mask = jnp.tril(jnp.ones((CHUNK, CHUNK), dtype=bool))[:, :, None]

    def step(S, inp):
        g, kk, vv = inp[:3]
        b = jnp.cumsum(g, axis=2)
        b_end = b[:, :, -1:, :]
        S_new = (jnp.exp(b_end[:, :, 0, :])[..., None] * S
                 + jnp.einsum("bhsk,bhsv->bhkv", kk * jnp.exp(b_end - b), vv))
        if q is None:
            return S_new, None
        qq = inp[3]
        decay = jnp.exp(jnp.where(mask, b[:, :, :, None, :] - b[:, :, None, :, :], -jnp.inf))
        scores = jnp.einsum("bhtk,bhtsk,bhsk->bhts", qq, decay, kk)
        o = (jnp.einsum("bhts,bhsv->bhtv", scores, vv)
             + jnp.einsum("bhtk,bhkv->bhtv", qq * jnp.exp(b), S))
        return S_new, o

    S_fin, o = lax.scan(step, s0, xs)
    if q is None:
        return None, S_fin
    return o.transpose(1, 0, 3, 2, 4).reshape(B, T, H, H_DV), S_fin


def _hgrn2_bidir(q_lat, f_lat, b_lat, v_lat, q_ctx, f_ctx, b_ctx, v_ctx):
    B = v_lat.shape[0]
    s0 = jnp.zeros((B, H_HEADS, H_DK, H_DV), jnp.float32)
    flip = lambda u: jnp.flip(u, axis=1)
    o_cf, s_f = _hgrn2_scan(q_ctx, f_ctx, v_ctx, s0)
    o_cb, s_b = _hgrn2_scan(None if q_ctx is None else flip(q_ctx), flip(b_ctx), flip(v_ctx), s0)
    o_lf, _ = _hgrn2_scan(q_lat, f_lat, v_lat, s_f)
    o_lb, _ = _hgrn2_scan(flip(q_lat), flip(b_lat), flip(v_lat), s_b)
    o_ctx = None if q_ctx is None else o_cf + flip(o_cb)
    return o_lf + flip(o_lb), o_ctx


def _merge(h, W, o_attn, o_hgrn, lam_init, subln_g, hgrn_g, w_ba, w_bh, w_o):
    B, T, _ = h.shape
    ya = (_rms(o_attn, subln_g) * (1.0 - lam_init)).reshape(B, T, A_WIDTH) * jax.nn.silu(h @ _cols(W, "attn_z"))
    yh = _rms(o_hgrn.astype(h.dtype), hgrn_g).reshape(B, T, H_WIDTH) * jax.nn.silu(h @ _cols(W, "hgrn_z"))
    g_a, g_h = jnp.split(jax.nn.sigmoid(h @ _cols(W, "merge_gate")), 2, axis=-1)
    return (g_a * (ya @ w_ba) + g_h * (yh @ w_bh)) @ w_o


def setup_inputs(seed: int = 0) -> dict:
    key = jax.random.key(seed)
    ks = jax.random.split(key, 24)
    D = D_MODEL

    def nrm(k, shape, s):
        return jax.random.normal(k, shape, jnp.float32) * s

    return {
        "x": nrm(ks[0], (BATCH, SEQ, D), 1.0),
        "c": nrm(ks[1], (BATCH, D), 1.0),
        "ctx": nrm(ks[2], (BATCH, CTX_LEN, D), 1.0),
        "c_ctx": nrm(ks[3], (D,), 1.0),
        "w_mod": nrm(ks[4], (DEPTH, D, 3 * D), D ** -0.5),
        "b_mod": nrm(ks[5], (DEPTH, 3 * D), 0.02),
        "norm_gain": 1.0 + nrm(ks[6], (DEPTH, D), 0.02),
        "w_in": nrm(ks[7], (DEPTH, D, IN_WIDTH), D ** -0.5),
        "q_norm_gain": 1.0 + nrm(ks[8], (DEPTH, A_DH), 0.02),
        "k_norm_gain": 1.0 + nrm(ks[9], (DEPTH, A_DH), 0.02),
        "lambda_q1": nrm(ks[10], (DEPTH, A_DH), 0.1),
        "lambda_k1": nrm(ks[11], (DEPTH, A_DH), 0.1),
        "lambda_q2": nrm(ks[12], (DEPTH, A_DH), 0.1),
        "lambda_k2": nrm(ks[13], (DEPTH, A_DH), 0.1),
        "subln_gain": 1.0 + nrm(ks[14], (DEPTH, A_DV), 0.02),
        "hgrn_lb_fwd": nrm(ks[15], (DEPTH + 1, H_HEADS * H_DK), 0.5),
        "hgrn_lb_bwd": nrm(ks[16], (DEPTH + 1, H_HEADS * H_DK), 0.5),
        "hgrn_norm_gain": 1.0 + nrm(ks[17], (DEPTH, H_DV), 0.02),
        "w_br_attn": nrm(ks[18], (DEPTH, A_WIDTH, D), A_WIDTH ** -0.5),
        "w_br_hgrn": nrm(ks[19], (DEPTH, H_WIDTH, D), H_WIDTH ** -0.5),
        "w_out": nrm(ks[20], (DEPTH, D, D), D ** -0.5),
    }


def reference(x, c, ctx, c_ctx, w_mod, b_mod, norm_gain, w_in, q_norm_gain, k_norm_gain,
              lambda_q1, lambda_k1, lambda_q2, lambda_k2, subln_gain, hgrn_lb_fwd, hgrn_lb_bwd,
              hgrn_norm_gain, w_br_attn, w_br_hgrn, w_out):
    B, T, _ = x.shape
    Lc = ctx.shape[1]
    cos, sin = _axial_rope(T)
    q_scale = A_DH ** -0.5
    f32 = jnp.float32
    for l in range(DEPTH):
        last = l == DEPTH - 1
        W = w_in[l]
        lam_init = 0.8 - 0.6 * math.exp(-0.3 * l)
        mod = jax.nn.silu(c) @ w_mod[l] + b_mod[l]
        shift, scale, gate = jnp.split(mod[:, None, :], 3, axis=-1)
        mod_c = jax.nn.silu(c_ctx) @ w_mod[l] + b_mod[l]
        shift_c, scale_c, gate_c = jnp.split(mod_c, 3, axis=-1)
        h = _rms(x, norm_gain[l]) * (1.0 + scale) + shift
        hc = _rms(ctx, norm_gain[l]) * (1.0 + scale_c) + shift_c

        lam = (jnp.exp(jnp.sum(lambda_q1[l].astype(f32) * lambda_k1[l].astype(f32)))
               - jnp.exp(jnp.sum(lambda_q2[l].astype(f32) * lambda_k2[l].astype(f32))) + lam_init)
        k_c = _qk_heads(hc @ _cols(W, "attn_k"), k_norm_gain[l])
        v_c = _v_heads(hc @ _cols(W, "attn_v"))
        q_l = _apply_rope(_qk_heads(h @ _cols(W, "attn_q"), q_norm_gain[l]), cos, sin) * q_scale
        k_l = _apply_rope(_qk_heads(h @ _cols(W, "attn_k"), k_norm_gain[l]), cos, sin)
        v_l = _v_heads(h @ _cols(W, "attn_v"))
        o_a = _diff_attention(q_l, jnp.concatenate([k_c, k_l], axis=3),
                              jnp.concatenate([v_c, v_l], axis=2), lam)

        lb_f = _lower_bound(hgrn_lb_fwd, l)
        lb_b = _lower_bound(hgrn_lb_bwd, l)
        q_h = jax.nn.silu(h @ _cols(W, "hgrn_q")).reshape(B, T, H_HEADS, H_DK)
        f_l = _log_forget(h @ _cols(W, "hgrn_f_fwd"), lb_f)
        b_l = _log_forget(h @ _cols(W, "hgrn_f_bwd"), lb_b)
        v_hl = (h @ _cols(W, "hgrn_i")).reshape(B, T, H_HEADS, H_DV)
        f_c = _log_forget(hc @ _cols(W, "hgrn_f_fwd"), lb_f)
        b_c = _log_forget(hc @ _cols(W, "hgrn_f_bwd"), lb_b)
        v_hc = (hc @ _cols(W, "hgrn_i")).reshape(B, Lc, H_HEADS, H_DV)
        q_hc = None if last else jax.nn.silu(hc @ _cols(W, "hgrn_q")).reshape(B, Lc, H_HEADS, H_DK)
        o_h, o_hc = _hgrn2_bidir(q_h, f_l, b_l, v_hl, q_hc, f_c, b_c, v_hc)

        y = _merge(h, W, o_a, o_h, lam_init, subln_gain[l], hgrn_norm_gain[l],
                   w_br_attn[l], w_br_hgrn[l], w_out[l])
        if not last:
            q_c = _qk_heads(hc @ _cols(W, "attn_q"), q_norm_gain[l]) * q_scale
            o_ac = _diff_attention(q_c, k_c, v_c, lam)
            ctx = ctx + gate_c * _merge(hc, W, o_ac, o_hc, lam_init, subln_gain[l], hgrn_norm_gain[l],
                                        w_br_attn[l], w_br_hgrn[l], w_out[l])
        x = x + gate * y
    return x
```

```cpp
#include <hip/hip_runtime.h>
#include <cstdio>
#include <cstdint>

#ifndef MK_ONE_LAUNCH
#define MK_ONE_LAUNCH 1
#endif

constexpr int NB = 8, T = 4096, D = 1024, LC = 256, S = LC + T, M = NB * T, MC = NB * LC, MALL = NB * S;
constexpr int NH = 8;
constexpr int NIN = 11264;
constexpr float EPS = 1e-6f;
constexpr float LAM_INIT = 0.2f;
constexpr float LOG2E = 1.4426950408889634f;

#define GAS __attribute__((address_space(1)))
#define LAS __attribute__((address_space(3)))
typedef unsigned short bf16_t;
typedef short bf16x8 __attribute__((ext_vector_type(8)));
typedef short s16x4 __attribute__((ext_vector_type(4)));
typedef float f32x4 __attribute__((ext_vector_type(4)));
typedef float f32x2 __attribute__((ext_vector_type(2)));
typedef float f32x16 __attribute__((ext_vector_type(16)));
typedef unsigned u32x4 __attribute__((ext_vector_type(4)));
typedef unsigned u32x2 __attribute__((ext_vector_type(2)));
typedef GAS unsigned gu32;

constexpr size_t MiB = 1u << 20;
constexpr size_t WS_CTL = 0, CTL_ZERO_BYTES = 1 * MiB;
constexpr size_t WS_PAR = 1 * MiB;
constexpr size_t WS_WIN = 2 * MiB;
constexpr size_t WS_WBA = 24 * MiB, WS_WBH = 26 * MiB, WS_WO = 28 * MiB;
constexpr size_t WS_HC = 30 * MiB;
constexpr size_t WS_KALL = 34 * MiB, WS_VALL = 102 * MiB, WS_IALL = 170 * MiB, WS_GF = 238 * MiB, WS_GB = 306 * MiB;
constexpr size_t WS_Q = 374 * MiB, WS_QH = 438 * MiB;
constexpr size_t WS_END = 502 * MiB;
constexpr size_t WS_YA = 34 * MiB, WS_YHH = 98 * MiB, WS_GA = 162 * MiB, WS_GH = 438 * MiB, WS_MM = 290 * MiB;
constexpr size_t OUT_H = 0, OUT_YH = 64 * MiB, OUT_GA = 64 * MiB;
constexpr int PAR_MOD = 0;
constexpr int PAR_LBF = 9 * 3072, PAR_LBB = PAR_LBF + 1024;
constexpr int PAR_ROPE = PAR_LBB + 1024;
constexpr int PAR_SCAL = PAR_ROPE + 2048;
constexpr int CW_BAR = 4096;

constexpr int RING_BYTES = 131072;
constexpr int LDSCTL_OFF = RING_BYTES, MISC_OFF = LDSCTL_OFF + 320;
constexpr int LDS_BYTES = 147456;
constexpr int XS_OFF = 136 * 1024;

#define LDS_WAIT() asm volatile("s_waitcnt lgkmcnt(0)" ::: "memory")
#define VM_WAIT() asm volatile("s_waitcnt vmcnt(0)" ::: "memory")
__device__ __forceinline__ unsigned f2bf(float f) { unsigned u = __builtin_bit_cast(unsigned, f); return (u + 0x7fffu + ((u >> 16) & 1u)) >> 16; }
__device__ __forceinline__ unsigned pk2(float lo, float hi) { return f2bf(lo) | (f2bf(hi) << 16); }
__device__ __forceinline__ float bf2f(unsigned short b) { return __builtin_bit_cast(float, (unsigned)b << 16); }
__device__ __forceinline__ float bflo(unsigned w) { return __builtin_bit_cast(float, w << 16); }
__device__ __forceinline__ float bfhi(unsigned w) { return __builtin_bit_cast(float, w & 0xffff0000u); }
__device__ __forceinline__ unsigned cvt_pk_bf16(float lo, float hi) { unsigned r; asm volatile("v_cvt_pk_bf16_f32 %0, %1, %2" : "=v"(r) : "v"(lo), "v"(hi)); return r; }
__device__ __forceinline__ unsigned pk_f16(float lo, float hi) { _Float16 a = (_Float16)lo, b = (_Float16)hi; return (unsigned)__builtin_bit_cast(unsigned short, a) | ((unsigned)__builtin_bit_cast(unsigned short, b) << 16); }
__device__ __forceinline__ float f16lo(unsigned w) { return (float)__builtin_bit_cast(_Float16, (unsigned short)(w & 0xffffu)); }
__device__ __forceinline__ float f16hi(unsigned w) { return (float)__builtin_bit_cast(_Float16, (unsigned short)(w >> 16)); }
__device__ __forceinline__ float sigmoidf_(float v) { return __builtin_amdgcn_rcpf(1.f + __builtin_amdgcn_exp2f(-v * LOG2E)); }
__device__ __forceinline__ float siluf_(float v) { return v * sigmoidf_(v); }
__device__ __forceinline__ float wave_sum(float v) {
#pragma unroll
    for (int o = 1; o < 64; o <<= 1) v += __shfl_xor(v, o);
    return v;
}

namespace pg8 {
constexpr int BM = 256, BK = 64, HALF = 128, HTB = HALF * BK * 2, STAGE_BYTES = 8 * HTB, NXCD = 8, WGM = 2;
__host__ __device__ __forceinline__ int lds_byte(int r, int c) { const int st = (r >> 4) * 2 + (c >> 5), rr = r & 15, cc = c & 31, ob = rr * 64 + cc * 2; return st * 1024 + (ob ^ (((ob >> 9) & 1) << 5)); }
__host__ __device__ __forceinline__ void stage_rc(int b, int& R, int& C) { const int st = b / 1024, sb = b % 1024, swz = sb ^ (((sb >> 9) & 1) << 5); R = (st >> 1) * 16 + swz / 64; C = (st & 1) * 32 + (swz % 64) / 2; }
__host__ __device__ __forceinline__ int perm32(int rho) { const int n = rho >> 4, i = rho & 15; return 8 * (i >> 2) + 4 * n + (i & 3); }

struct Unit { int pm, pn, kind; const char* A; const char* B; };

__device__ __forceinline__ void tile_map(int wgid_in, int nM, int nN, int& pm, int& pn) {
    const int nwg = nM * nN; int wgid = wgid_in;
    { const int q = nwg / NXCD, r = nwg % NXCD, xcd = wgid % NXCD, off = wgid / NXCD; wgid = (xcd < r ? xcd * (q + 1) : r * (q + 1) + (xcd - r) * q) + off; }
    const int nig = WGM * nN, gid = wgid / nig, fm = gid * WGM, gsz = (nM - fm) < WGM ? (nM - fm) : WGM;
    pm = fm + ((wgid % nig) % gsz); pn = (wgid % nig) / gsz;
}

template <class Epi, class Sched, bool ALIGN_EPI, bool SP2>
__device__ __forceinline__ void gemm_phase(LAS unsigned char* lds, const int K, const Sched& S, const Epi& E) {
    int tid_ = threadIdx.x; asm volatile("" : "+v"(tid_));
    const int tid = tid_, wid = __builtin_amdgcn_readfirstlane(tid >> 6), lane = tid & 63, wr = wid >> 2, wc = wid & 3, fr = lane & 15, fq = lane >> 4;
    const int nt = K / BK;
    unsigned voffA[2], voffB[2];
#pragma unroll
    for (int i = 0; i < 2; ++i) { int R, C; stage_rc(tid * 16 + i * 8192, R, C); const int Rb = Epi::PERM ? ((R & ~31) + perm32(R & 31)) : R;
        voffA[i] = (unsigned)(R * K + C) * 2u; voffB[i] = (unsigned)(Rb * K + C) * 2u; }
    const size_t kstep = (size_t)(BK * 2);
    const size_t hstep = (size_t)HALF * K * 2;
    const unsigned ldsw = (unsigned)wid * 1024u;
    const int aoff = lds_byte(wr * 64 + fr, fq * 8), boff = lds_byte(wc * 32 + fr, fq * 8);
#define PG8_SA(b, h) (((b) * 2 + (h)) * HTB)
#define PG8_SB(b, h) ((4 + (b) * 2 + (h)) * HTB)
#define PG8_STAGE(bufoff, gbase, voff) do { _Pragma("unroll") for (int _i = 0; _i < 2; ++_i) \
        __builtin_amdgcn_global_load_lds((const unsigned*)((const char*)(gbase) + (voff)[_i]), (LAS unsigned*)(lds + (bufoff) + ldsw + _i * 8192), 16, 0, 0); } while (0)
#define PG8_LDA(dst, b, h) do { _Pragma("unroll") for (int m = 0; m < 4; ++m) _Pragma("unroll") for (int k = 0; k < 2; ++k) dst[m][k] = *(const LAS bf16x8*)(lds + PG8_SA(b, h) + aoff + m * 2048 + k * 1024); } while (0)
#define PG8_LDB(dst, b, h) do { _Pragma("unroll") for (int n = 0; n < 2; ++n) _Pragma("unroll") for (int k = 0; k < 2; ++k) dst[n][k] = *(const LAS bf16x8*)(lds + PG8_SB(b, h) + boff + n * 2048 + k * 1024); } while (0)
#define PG8_MMA(ai, bj, At, Bt) do { __builtin_amdgcn_s_setprio(1); _Pragma("unroll") for (int m = 0; m < 4; ++m) _Pragma("unroll") for (int n = 0; n < 2; ++n) _Pragma("unroll") for (int k = 0; k < 2; ++k) \
        acc[ai][bj][m][n] = __builtin_amdgcn_mfma_f32_16x16x32_bf16(Bt[n][k], At[m][k], acc[ai][bj][m][n], 0, 0, 0); __builtin_amdgcn_s_setprio(0); } while (0)
#define PG8_WAIT_V(n) asm volatile("s_waitcnt vmcnt(" #n ")" ::: "memory")
#define PG8_WAIT_L(n) asm volatile("s_waitcnt lgkmcnt(" #n ")" ::: "memory")
#define PG8_BAR __builtin_amdgcn_s_barrier()
#define PG8_SCHED __builtin_amdgcn_sched_barrier(0)
    Unit cur, nxt; int ui = 0;
    if (!S.next(0, cur)) return;
    f32x4 acc[2][2][4][2];
#pragma unroll
    for (int a = 0; a < 2; ++a)
#pragma unroll
        for (int b = 0; b < 2; ++b)
#pragma unroll
            for (int m = 0; m < 4; ++m)
#pragma unroll
                for (int n = 0; n < 2; ++n) acc[a][b][m][n] = (f32x4){0.f, 0.f, 0.f, 0.f};
    bf16x8 At[4][2], B0[2][2], B1[2][2];
    const char* cA = cur.A; const char* cB = cur.B;
    if constexpr (SP2) {
        PG8_STAGE(PG8_SB(0, 0), cB, voffB); PG8_STAGE(PG8_SB(0, 1), cB + hstep, voffB); PG8_STAGE(PG8_SA(0, 0), cA, voffA); PG8_STAGE(PG8_SA(0, 1), cA + hstep, voffA);
        if (wr == 1) PG8_BAR;
        PG8_WAIT_V(2); PG8_BAR;
        PG8_STAGE(PG8_SB(1, 0), cB + kstep, voffB); PG8_STAGE(PG8_SA(1, 0), cA + kstep, voffA); PG8_STAGE(PG8_SB(1, 1), cB + hstep + kstep, voffB);
        PG8_WAIT_V(6); PG8_BAR;
    } else {
        PG8_STAGE(PG8_SB(0, 0), cB, voffB); PG8_STAGE(PG8_SA(0, 0), cA, voffA); PG8_STAGE(PG8_SB(0, 1), cB + hstep, voffB); PG8_STAGE(PG8_SA(0, 1), cA + hstep, voffA);
        if (wr == 1) PG8_BAR;
        PG8_WAIT_V(4); PG8_BAR;
        PG8_STAGE(PG8_SB(1, 0), cB + kstep, voffB); PG8_STAGE(PG8_SA(1, 0), cA + kstep, voffA); PG8_STAGE(PG8_SB(1, 1), cB + hstep + kstep, voffB);
        PG8_WAIT_V(6); PG8_BAR;
    }
    for (;;) {
        const bool has_next = S.next(ui + 1, nxt);
        const char* nA = has_next ? nxt.A : cA; const char* nB = has_next ? nxt.B : cB;
        for (int t = 0; t < nt; t += 2) {
            if constexpr (Epi::MID) { if (t == nt / 2) E.mid(acc, cur, wr, wc, fr, fq); }
            const bool last = (t == nt - 2);
            const char* a1 = cA + (size_t)(t + 1) * kstep;
            const char* a2 = last ? nA : cA + (size_t)(t + 2) * kstep; const char* b2 = last ? nB : cB + (size_t)(t + 2) * kstep;
            const char* a3 = a2 + kstep; const char* b3 = b2 + kstep;
            if constexpr (SP2) {
            PG8_LDB(B0, 0, 0); PG8_LDB(B1, 0, 1); PG8_SCHED; PG8_LDA(At, 0, 0); PG8_STAGE(PG8_SA(1, 1), a1 + hstep, voffA);
            PG8_WAIT_V(8); PG8_WAIT_L(0); PG8_BAR; PG8_MMA(0, 0, At, B0); PG8_MMA(0, 1, At, B1); PG8_BAR; PG8_SCHED;
            PG8_LDA(At, 0, 1); PG8_STAGE(PG8_SB(0, 0), b2, voffB); PG8_STAGE(PG8_SB(0, 1), b2 + hstep, voffB); PG8_STAGE(PG8_SA(0, 0), a2, voffA);
            PG8_WAIT_V(8); PG8_WAIT_L(0); PG8_BAR; PG8_MMA(1, 0, At, B0); PG8_MMA(1, 1, At, B1); PG8_BAR; PG8_SCHED;
            PG8_LDB(B0, 1, 0); PG8_LDB(B1, 1, 1); PG8_SCHED; PG8_LDA(At, 1, 0); PG8_STAGE(PG8_SA(0, 1), a2 + hstep, voffA);
            PG8_WAIT_V(8); PG8_WAIT_L(0); PG8_BAR; PG8_MMA(0, 0, At, B0); PG8_MMA(0, 1, At, B1); PG8_BAR; PG8_SCHED;
            PG8_LDA(At, 1, 1); PG8_STAGE(PG8_SB(1, 0), b3, voffB); PG8_STAGE(PG8_SB(1, 1), b3 + hstep, voffB); PG8_STAGE(PG8_SA(1, 0), a3, voffA);
            PG8_WAIT_V(8); PG8_WAIT_L(0); PG8_BAR; PG8_MMA(1, 0, At, B0); PG8_MMA(1, 1, At, B1); PG8_BAR; PG8_SCHED;
            } else {
            PG8_LDB(B0, 0, 0); PG8_SCHED; PG8_LDA(At, 0, 0); PG8_STAGE(PG8_SA(1, 1), a1 + hstep, voffA);
            PG8_WAIT_L(8); PG8_BAR; PG8_WAIT_L(0); PG8_MMA(0, 0, At, B0); PG8_BAR; PG8_SCHED;
            PG8_LDB(B1, 0, 1); PG8_STAGE(PG8_SB(0, 0), b2, voffB);
            PG8_BAR; PG8_WAIT_L(0); PG8_MMA(0, 1, At, B1); PG8_BAR;
            PG8_LDA(At, 0, 1); PG8_STAGE(PG8_SA(0, 0), a2, voffA);
            PG8_BAR; PG8_WAIT_L(0); PG8_MMA(1, 0, At, B0); PG8_BAR; PG8_SCHED;
            PG8_STAGE(PG8_SB(0, 1), b2 + hstep, voffB);
            PG8_WAIT_V(6); PG8_BAR; PG8_MMA(1, 1, At, B1); PG8_BAR;
            PG8_LDB(B0, 1, 0); PG8_SCHED; PG8_LDA(At, 1, 0); PG8_STAGE(PG8_SA(0, 1), a2 + hstep, voffA);
            PG8_WAIT_L(8); PG8_BAR; PG8_WAIT_L(0); PG8_MMA(0, 0, At, B0); PG8_BAR; PG8_SCHED;
            PG8_LDB(B1, 1, 1); PG8_STAGE(PG8_SB(1, 0), b3, voffB);
            PG8_BAR; PG8_WAIT_L(0); PG8_MMA(0, 1, At, B1); PG8_BAR;
            PG8_LDA(At, 1, 1); PG8_STAGE(PG8_SA(1, 0), a3, voffA);
            PG8_BAR; PG8_WAIT_L(0); PG8_MMA(1, 0, At, B0); PG8_BAR; PG8_SCHED;
            PG8_STAGE(PG8_SB(1, 1), b3 + hstep, voffB);
            PG8_WAIT_V(6); PG8_BAR; PG8_MMA(1, 1, At, B1); PG8_BAR;
            }
        }
        if constexpr (ALIGN_EPI) { if (wr == 0) PG8_BAR; }
        E(acc, cur, wr, wc, fr, fq);
        if (!has_next) break;
#pragma unroll
        for (int a = 0; a < 2; ++a)
#pragma unroll
            for (int b = 0; b < 2; ++b)
#pragma unroll
                for (int m = 0; m < 4; ++m)
#pragma unroll
                    for (int n = 0; n < 2; ++n) acc[a][b][m][n] = (f32x4){0.f, 0.f, 0.f, 0.f};
        cur = nxt; cA = nA; cB = nB; ++ui;
        if constexpr (ALIGN_EPI) { if (wr == 1) PG8_BAR; }
    }
    PG8_WAIT_V(0);
    if constexpr (!ALIGN_EPI) { if (wr == 0) PG8_BAR; }
    PG8_BAR;
#undef PG8_SA
#undef PG8_SB
#undef PG8_STAGE
#undef PG8_LDA
#undef PG8_LDB
#undef PG8_MMA
#undef PG8_WAIT_V
#undef PG8_WAIT_L
#undef PG8_BAR
#undef PG8_SCHED
}
}

#define XB_TMO      128
#define XB_XCNT(j)  (256  + 64 * (j))
#define XB_XSUB(j)  (1280 + 64 * (j))
#define XB_XGEN(j)  (2304 + 64 * (j))
#define XB_TOP      3328
#define XB_TOPGEN   3392
#define XCD_BAR_WORDS 3456
#define XB_SPIN_CAP (1u << 20)
__device__ __forceinline__ unsigned xb_ld(unsigned* p)              { return __hip_atomic_load(p, __ATOMIC_RELAXED, __HIP_MEMORY_SCOPE_AGENT); }
__device__ __forceinline__ unsigned xb_add(unsigned* p, unsigned v) { return __hip_atomic_fetch_add(p, v, __ATOMIC_RELAXED, __HIP_MEMORY_SCOPE_AGENT); }
__device__ __forceinline__ unsigned xb_xcc_id() { return (unsigned)__builtin_amdgcn_s_getreg((3 << 11) | 20) & 0xFu; }
#define XB_SPIN(cond, bar) do { unsigned _sp = 0; while (cond) { __builtin_amdgcn_s_sleep(1); \
    if ((++_sp & 255u) == 0u) { if (xb_ld(&(bar)[XB_TMO])) break; if (_sp > XB_SPIN_CAP) { atomicAdd(&(bar)[XB_TMO], 1u); break; } } } } while (0)
struct XcdBarrier { unsigned* bar; unsigned x; volatile LAS unsigned* st; };
__device__ __forceinline__ XcdBarrier xcd_barrier_post(unsigned* bar, volatile LAS unsigned* st) {
    XcdBarrier b; b.bar = bar; b.x = xb_xcc_id(); b.st = st;
    if (threadIdx.x == 0) (void)xb_add(&bar[XB_XCNT(b.x)], 1u);
    return b;
}
__device__ __forceinline__ void xcd_barrier_complete(unsigned* bar, unsigned x, unsigned& nloc, unsigned& nx) {
    const unsigned G = gridDim.x * gridDim.y * gridDim.z;
    unsigned sum, cnt, mine, sp = 0u;
    for (;;) {
        sum = 0u; cnt = 0u; mine = 0u;
#pragma unroll
        for (unsigned j = 0; j < 16; ++j) { const unsigned c = xb_ld(&bar[XB_XCNT(j)]); sum += c; cnt += (c > 0u) ? 1u : 0u; mine = (j == x) ? c : mine; }
        if (sum == G) break;
        __builtin_amdgcn_s_sleep(1);
        if ((++sp & 255u) == 0u) { if (xb_ld(&bar[XB_TMO])) break; if (sp > XB_SPIN_CAP) { atomicAdd(&bar[XB_TMO], 1u); break; } }
    }
    nloc = mine > 0u ? mine : 1u; nx = cnt > 0u ? cnt : 1u;
}
__device__ __forceinline__ void xcd_barrier(const XcdBarrier& b) {
    asm volatile("s_waitcnt vmcnt(0)" ::: "memory");
    __syncthreads();
    if (threadIdx.x == 0) {
        unsigned* bar = b.bar;
        __builtin_amdgcn_s_waitcnt(0);
        unsigned nloc = b.st[0], nx = b.st[1];
        if (nloc == 0u) { xcd_barrier_complete(bar, b.x, nloc, nx); b.st[0] = nloc; b.st[1] = nx; }
        const unsigned old = xb_add(&bar[XB_XSUB(b.x)], 1u);
        const unsigned gen = old / nloc;
        if (old + 1u == (gen + 1u) * nloc) {
            __builtin_amdgcn_fence(__ATOMIC_RELEASE, "agent");
            asm volatile("s_waitcnt vmcnt(0)" ::: "memory");
            const unsigned og = xb_add(&bar[XB_TOP], 1u);
            const unsigned tg = og / nx;
            if (og + 1u == (tg + 1u) * nx) xb_add(&bar[XB_TOPGEN], 1u);
            else XB_SPIN(xb_ld(&bar[XB_TOPGEN]) == tg, bar);
            __builtin_amdgcn_fence(__ATOMIC_ACQUIRE, "agent");
            xb_add(&bar[XB_XGEN(b.x)], 1u);
            asm volatile("s_waitcnt vmcnt(0)" ::: "memory");
        } else {
            XB_SPIN(xb_ld(&bar[XB_XGEN(b.x)]) == gen, bar);
            __builtin_amdgcn_fence(__ATOMIC_ACQUIRE, "agent");
            asm volatile("s_waitcnt vmcnt(0)" ::: "memory");
        }
    }
    __syncthreads();
}

struct Args { const float* in[21]; float* out; unsigned char* ws; int ph_lo, ph_hi; };
struct Frame {
    LAS unsigned char* lds; unsigned char* ldsg;
    int tid, lane, wave, vcu, G;
    const float* in[21]; unsigned char* ws; unsigned char* outb; float* par;
};
enum { IN_X = 0, IN_C, IN_CTX, IN_CCTX, IN_WMOD, IN_BMOD, IN_NG, IN_WIN, IN_QG, IN_KG, IN_LQ1, IN_LK1, IN_LQ2, IN_LK2, IN_SUBG, IN_LBF, IN_LBB, IN_HG, IN_WBA, IN_WBH, IN_WO };

__device__ __forceinline__ int qk_slot(int l) { return 128 * ((l >> 5) & 1) + 32 * (l >> 6) + 8 * ((l >> 2) & 3) + 4 * ((l >> 4) & 1) + (l & 3); }
template <bool QKPERM>
__device__ __forceinline__ void p0_transpose_item(const float* W, int K, int N, bf16_t* WT, LAS float* scr, int item, int lane, const int opitch) {
    const int nblk = N / 32, kb = item / nblk, nb = item % nblk, k0 = 64 * kb, n0 = 32 * nb;
    float wv[32];
#pragma unroll
    for (int i = 0; i < 32; ++i) wv[i] = W[(size_t)(k0 + 2 * i + (lane >> 5)) * N + n0 + (lane & 31)];
#pragma unroll
    for (int i = 0; i < 32; ++i) scr[(2 * i + (lane >> 5)) * 33 + (lane & 31)] = wv[i];
    LDS_WAIT(); asm volatile("" ::: "memory");
    const int c = lane & 7;
#pragma unroll
    for (int j = 0; j < 4; ++j) { const int n = (lane >> 3) + 8 * j; const LAS float* s = scr + (8 * c) * 33 + n;
        u32x4 o; o.x = pk2(s[0 * 33], s[1 * 33]); o.y = pk2(s[2 * 33], s[3 * 33]); o.z = pk2(s[4 * 33], s[5 * 33]); o.w = pk2(s[6 * 33], s[7 * 33]);
        int nd = n0 + n; if constexpr (QKPERM) { if (nd < 1024 || (nd >= 5120 && nd < 6144)) nd = (nd & ~255) + qk_slot(nd & 255); }
        *(GAS u32x4*)(WT + (size_t)nd * opitch + k0 + 8 * c) = o; }
    LDS_WAIT(); asm volatile("" ::: "memory");
}
__device__ __forceinline__ void p0_weights(Frame& F) {
    {
        LAS float* scr = (LAS float*)(F.lds + F.wave * 16384);
        const int gw = F.vcu * 8 + F.wave, NGW = F.G * 8;
        constexpr int I_IN = (D / 64) * (NIN / 32), I_SQ = (D / 64) * (D / 32);
        constexpr int NITEMS = I_IN + 3 * I_SQ;
        for (int it = gw; it < NITEMS; it += NGW) {
            int r = it;
            if (r < I_IN) { p0_transpose_item<true>(F.in[IN_WIN], D, NIN, (bf16_t*)(F.ws + WS_WIN), scr, r, F.lane, D); continue; } r -= I_IN;
            if (r < I_SQ) { p0_transpose_item<false>(F.in[IN_WBA], D, D, (bf16_t*)(F.ws + WS_WBA), scr, r, F.lane, 2 * D); continue; } r -= I_SQ;
            if (r < I_SQ) { p0_transpose_item<false>(F.in[IN_WBH], D, D, (bf16_t*)(F.ws + WS_WBA) + D, scr, r, F.lane, 2 * D); continue; } r -= I_SQ;
            p0_transpose_item<false>(F.in[IN_WO], D, D, (bf16_t*)(F.ws + WS_WO), scr, r, F.lane, D);
        }
    }
}
__device__ __forceinline__ void p0a(Frame& F) {
    const int j = (int)blockIdx.x;
    if (j < 96) {
        LAS float* sc = (LAS float*)F.lds;
        LAS float* red = (LAS float*)(F.lds + 40960);
        { float cv[18];
#pragma unroll
          for (int q = 0; q < 18; ++q) { const int i = F.tid + 512 * q, k = i & 1023; cv[q] = (q < 16) ? F.in[IN_C][(q >> 1) * 1024 + k] : F.in[IN_CCTX][k]; }
#pragma unroll
          for (int q = 0; q < 18; ++q) sc[F.tid + 512 * q] = cv[q] / (1.f + __expf(-cv[q])); }
        __syncthreads();
        const int col = F.tid & 31, ks = F.tid >> 5, n = 32 * j + col;
        float acc[9];
#pragma unroll
        for (int r = 0; r < 9; ++r) acc[r] = 0.f;
        const float* wm = F.in[IN_WMOD];
        for (int kb = 0; kb < 64; kb += 16) {
            float w[16];
#pragma unroll
            for (int u = 0; u < 16; ++u) w[u] = wm[(size_t)(ks * 64 + kb + u) * 3072 + n];
#pragma unroll
            for (int u = 0; u < 16; ++u) { const int k = ks * 64 + kb + u;
#pragma unroll
                for (int r = 0; r < 9; ++r) acc[r] += sc[r * 1024 + k] * w[u]; } }
#pragma unroll
        for (int r = 0; r < 9; ++r) red[(ks * 9 + r) * 32 + col] = acc[r];
        __syncthreads();
        if (F.tid < 288) { const int r = F.tid >> 5, c2 = F.tid & 31; float s = 0.f;
#pragma unroll
            for (int q = 0; q < 16; ++q) s += red[(q * 9 + r) * 32 + c2];
            F.par[PAR_MOD + r * 3072 + 32 * j + c2] = s + F.in[IN_BMOD][32 * j + c2]; }
        __syncthreads();
    } else if (j == 96) {
        for (int i = F.tid; i < 1024; i += 512) {
            { const float p0 = F.in[IN_LBF][i], p1 = F.in[IN_LBF][1024 + i]; F.par[PAR_LBF + i] = 1.f / (1.f + expf(p1 - p0)); }
            { const float p0 = F.in[IN_LBB][i], p1 = F.in[IN_LBB][1024 + i]; F.par[PAR_LBB + i] = 1.f / (1.f + expf(p1 - p0)); }
            { const int pos = i >> 4, fi = i & 15; const double inv = exp(-(double)(2 * fi) / 32.0 * log(10000.0)); const double ang = (double)pos * inv;
              F.par[PAR_ROPE + 2 * i] = (float)cos(ang); F.par[PAR_ROPE + 2 * i + 1] = (float)sin(ang); }
        }
        if (F.tid < 64) {
            const int l = F.tid;
            const float d1 = wave_sum(F.in[IN_LQ1][l] * F.in[IN_LK1][l]), d2 = wave_sum(F.in[IN_LQ2][l] * F.in[IN_LK2][l]);
            float mq = fabsf(F.in[IN_QG][l]), mk = fabsf(F.in[IN_KG][l]);
#pragma unroll
            for (int o = 1; o < 64; o <<= 1) { mq = fmaxf(mq, __shfl_xor(mq, o)); mk = fmaxf(mk, __shfl_xor(mk, o)); }
            if (l == 0) { F.par[PAR_SCAL] = expf(d1) - expf(d2) + LAM_INIT; F.par[PAR_SCAL + 1] = 8.f * mq * mk * LOG2E * 1.01f; }
        }
    }
}
__device__ __forceinline__ void p0b(Frame& F) {
    const int gw = F.vcu * 8 + F.wave, NGW = F.G * 8;
    const GAS f32x4* gn = (const GAS f32x4*)F.in[IN_NG] + F.lane;
    for (int m0 = gw; m0 < M + MC; m0 += 2 * NGW) {
        f32x4 v[2][4]; float rstd[2]; const int mm[2] = {m0, m0 + NGW};
#pragma unroll
        for (int q = 0; q < 2; ++q) { const int m = mm[q] < M + MC ? mm[q] : m0; const float* xrow = (m < M) ? F.in[IN_X] + (size_t)m * D : F.in[IN_CTX] + (size_t)(m - M) * D;
            const GAS f32x4* xr = (const GAS f32x4*)xrow + F.lane;
#pragma unroll
            for (int j = 0; j < 4; ++j) v[q][j] = xr[64 * j]; }
#pragma unroll
        for (int q = 0; q < 2; ++q) { float s = 0.f;
#pragma unroll
            for (int j = 0; j < 4; ++j) s += (v[q][j].x * v[q][j].x + v[q][j].y * v[q][j].y) + (v[q][j].z * v[q][j].z + v[q][j].w * v[q][j].w);
            rstd[q] = 1.f / sqrtf(wave_sum(s) * (1.f / D) + EPS); }
#pragma unroll
        for (int q = 0; q < 2; ++q) { const int m = mm[q]; if (m >= M + MC) break;
            const bool lat = m < M; const int mr = lat ? (m >> 12) : 8;
            bf16_t* orow = lat ? (bf16_t*)(F.outb + OUT_H) + (size_t)m * D : (bf16_t*)(F.ws + WS_HC) + (size_t)(m - M) * D;
            const GAS f32x4* sh = (const GAS f32x4*)(F.par + PAR_MOD + mr * 3072) + F.lane;
            const GAS f32x4* scl = (const GAS f32x4*)(F.par + PAR_MOD + mr * 3072 + 1024) + F.lane;
            GAS u32x2* o8 = (GAS u32x2*)orow + F.lane;
#pragma unroll
            for (int j = 0; j < 4; ++j) { const f32x4 g = gn[64 * j], a = scl[64 * j], b = sh[64 * j];
                const f32x4 h = v[q][j] * rstd[q] * g * (a + 1.f) + b;
                u32x2 w; w.x = pk2(h.x, h.y); w.y = pk2(h.z, h.w); o8[64 * j] = w; } }
    }
}

struct SchedIn {
    int G, c; const char* H; const char* HC; const char* W;
    __device__ __forceinline__ bool next(int i, pg8::Unit& u) const {
        const int L = i * G + c; constexpr int NLAT = 128 * 28, NCTX = 8 * 20;
        if (L >= NLAT + NCTX) return false;
        if (L < NLAT) { pg8::tile_map(L, 128, 28, u.pm, u.pn); u.kind = 0; u.A = H + (size_t)u.pm * (256 * 1024 * 2); }
        else { const int r = L - NLAT; u.pm = r & 7; u.pn = r >> 3; u.kind = 1; u.A = HC + (size_t)u.pm * (256 * 1024 * 2); }
        u.B = W + (size_t)u.pn * (256 * 1024 * 2); return true;
    }
};
template <int MODE> struct EpiProbe {
    static constexpr bool PERM = true, MID = false;
    unsigned char* scratch;
    __device__ __forceinline__ void operator()(const f32x4 (&acc)[2][2][4][2], const pg8::Unit& u, int wr, int wc, int fr, int fq) const {
        if constexpr (MODE == 3) {
#pragma unroll
            for (int ai = 0; ai < 2; ++ai)
#pragma unroll
                for (int bj = 0; bj < 2; ++bj)
#pragma unroll
                    for (int m = 0; m < 4; ++m) asm volatile("" :: "v"(acc[ai][bj][m][0]), "v"(acc[ai][bj][m][1]));
            return; }
        bf16_t* base = (bf16_t*)scratch; const int row0 = (u.pm & 127) * 256 + wr * 64 + fr, cg0 = (u.pn & 3) * 256 + wc * 32 + 8 * fq;
#pragma unroll
        for (int ai = 0; ai < 2; ++ai)
#pragma unroll
            for (int m = 0; m < 4; ++m) { bf16_t* rowp = base + (size_t)(row0 + ai * 128 + m * 16) * 1024 + cg0;
#pragma unroll
                for (int bj = 0; bj < 2; ++bj) { const f32x4 v0 = acc[ai][bj][m][0], v1 = acc[ai][bj][m][1]; u32x4 w;
                    w.x = cvt_pk_bf16(v0[0], v0[1]); w.y = cvt_pk_bf16(v0[2], v0[3]); w.z = cvt_pk_bf16(v1[0], v1[1]); w.w = cvt_pk_bf16(v1[2], v1[3]);
                    *(u32x4*)(rowp + bj * 128) = w; } }
    }
};
struct EpiIn {
    static constexpr bool PERM = true, MID = false;
    unsigned char* ws; const float* par; const float* kgain; const float* qgain;
    __device__ __forceinline__ void qk_epi(const f32x4 (&acc)[2][2][4][2], const pg8::Unit& u, int wr, int wc, int fr, int fq, const bool isq) const {
        const int head = (u.pn & 3) * 2 + (wc >> 1), map = wc & 1;
        const float gs = isq ? 0.125f * LOG2E : 1.f; const float* gp = (isq ? qgain : kgain) + 4 * fq;
        const bool rope = (u.kind == 0);
        unsigned char* ub; int rs;
        if (isq) { ub = ws + WS_Q + ((size_t)(u.pm * 256 + wr * 64) * 1024 + head * 128 + map * 64) * 2; rs = 1024; }
        else { const int bb = rope ? (u.pm >> 4) : u.pm, s0 = rope ? LC + (u.pm & 15) * 256 : 0; ub = ws + WS_KALL + (((size_t)(bb * NH + head) * S + s0 + wr * 64) * 128 + map * 64) * 2; rs = 128; }
        const unsigned loff = (unsigned)(fr * rs + 4 * fq) * 2u;
#pragma unroll
        for (int ai = 0; ai < 2; ++ai)
#pragma unroll
            for (int m = 0; m < 4; ++m) {
                const int lr = ai * 128 + wr * 64 + m * 16 + fr;
                float ss = 0.f;
#pragma unroll
                for (int bj = 0; bj < 2; ++bj)
#pragma unroll
                    for (int n = 0; n < 2; ++n) { const f32x4 x = acc[ai][bj][m][n]; ss += (x[0] * x[0] + x[1] * x[1]) + (x[2] * x[2] + x[3] * x[3]); }
                ss += __shfl_xor(ss, 16); ss += __shfl_xor(ss, 32);
                const float rstd = gs / sqrtf(ss * (1.f / 64.f) + EPS);
                const int tpos = (u.pm & 15) * 256 + lr;
                unsigned char* rowp = ub + (size_t)((ai * 128 + m * 16) * rs * 2) + loff;
#pragma unroll
                for (int bj = 0; bj < 2; ++bj) {
                    f32x4 a = acc[ai][bj][m][0] * rstd * *(const f32x4*)(gp + 32 * bj), bq = acc[ai][bj][m][1] * rstd * *(const f32x4*)(gp + 32 * bj + 16);
                    if (rope) { const int pos = bj ? (tpos & 63) : (tpos >> 6);
                        const f32x4 c0 = *(const f32x4*)(par + PAR_ROPE + pos * 32 + 8 * fq), c1 = *(const f32x4*)(par + PAR_ROPE + pos * 32 + 8 * fq + 4);
                        const f32x4 cs = (f32x4){c0[0], c0[2], c1[0], c1[2]}, sn = (f32x4){c0[1], c0[3], c1[1], c1[3]};
                        const f32x4 a2 = a * cs - bq * sn; bq = bq * cs + a * sn; a = a2; }
                    u32x2 w0, w1; w0.x = cvt_pk_bf16(a[0], a[1]); w0.y = cvt_pk_bf16(a[2], a[3]); w1.x = cvt_pk_bf16(bq[0], bq[1]); w1.y = cvt_pk_bf16(bq[2], bq[3]);
                    *(u32x2*)(rowp + 64 * bj) = w0; *(u32x2*)(rowp + 64 * bj + 32) = w1; }
            }
    }
    __device__ __forceinline__ void operator()(const f32x4 (&acc)[2][2][4][2], const pg8::Unit& u, int wr, int wc, int fr, int fq) const {
        const int grp = u.pn >> 2, cg0 = (u.pn & 3) * 256 + wc * 32 + 8 * fq;
        if (grp == 0 || grp == 5) { qk_epi(acc, u, wr, wc, fr, fq, grp == 5); return; }
        unsigned char* ub; size_t hstride;
        { const int hd0 = (u.pn & 3) * 2;
          if (grp < 5) { const int bb = (u.kind == 0) ? (u.pm >> 4) : u.pm, s0 = (u.kind == 0) ? LC + (u.pm & 15) * 256 : 0;
              ub = ws + WS_KALL + (size_t)grp * (68 * MiB) + (((size_t)(bb * NH + hd0) * S + s0 + wr * 64) * 128 + wc * 32) * 2; hstride = (size_t)S * 256; }
          else { ub = ws + WS_QH + (((size_t)((u.pm >> 4) * NH + hd0) * T + (u.pm & 15) * 256 + wr * 64) * 128 + wc * 32) * 2; hstride = (size_t)T * 256; } }
        const unsigned loff = (unsigned)(fr * 128 + 8 * fq) * 2u;
#pragma unroll
        for (int ai = 0; ai < 2; ++ai)
#pragma unroll
            for (int m = 0; m < 4; ++m) { unsigned char* rowp = ub + (size_t)((ai * 128 + m * 16) * 256) + loff;
#pragma unroll
                for (int bj = 0; bj < 2; ++bj) { f32x4 v0 = acc[ai][bj][m][0], v1 = acc[ai][bj][m][1]; u32x4 w;
                    if (grp == 3 || grp == 4) {
                        w.x = pk_f16(v0[0], v0[1]); w.y = pk_f16(v0[2], v0[3]); w.z = pk_f16(v1[0], v1[1]); w.w = pk_f16(v1[2], v1[3]);
                    } else {
                        if (grp == 6) {
#pragma unroll
                            for (int e = 0; e < 4; ++e) { v0[e] = siluf_(v0[e]); v1[e] = siluf_(v1[e]); }
                        }
                        w.x = cvt_pk_bf16(v0[0], v0[1]); w.y = cvt_pk_bf16(v0[2], v0[3]); w.z = cvt_pk_bf16(v1[0], v1[1]); w.w = cvt_pk_bf16(v1[2], v1[3]);
                    }
                    *(u32x4*)(rowp + bj * hstride) = w; } }
    }
};

namespace attn {
constexpr int LDK = 128, KVBLK = 64;
constexpr int SHM_V = KVBLK * 128 * 2, SHM_K = KVBLK * 128 * 2;
#define KSWZ(row, colB) ((row) * 256 + ((colB) ^ (((row) & 15) << 4)))
#define SBAR() __builtin_amdgcn_sched_barrier(0)
__device__ __forceinline__ int crow(int r, int hi) { return (r & 3) + 8 * (r >> 2) + 4 * hi; }
__device__ __forceinline__ void expA_(f32x16& p0) {
#pragma unroll
    for (int r = 0; r < 16; ++r) p0[r] = __builtin_amdgcn_exp2f(p0[r]);
}
template <bool NOEXP>
__device__ __forceinline__ void finishSM_(f32x16& p0, f32x16& p1, float& l_reg, bf16x8& pa0, bf16x8& pa1, bf16x8& pa2, bf16x8& pa3) {
    if constexpr (!NOEXP) {
#pragma unroll
    for (int r = 0; r < 16; ++r) p1[r] = __builtin_amdgcn_exp2f(p1[r]); }
    float ps = 0;
#pragma unroll
    for (int r = 0; r < 16; ++r) ps += p0[r];
#pragma unroll
    for (int r = 0; r < 16; ++r) ps += p1[r];
    l_reg += ps;
#define PK4(P, BASE, OUT) do { unsigned a0 = cvt_pk_bf16(P[BASE + 0], P[BASE + 1]), a1 = cvt_pk_bf16(P[BASE + 2], P[BASE + 3]);   \
    unsigned b0 = cvt_pk_bf16(P[BASE + 4], P[BASE + 5]), b1 = cvt_pk_bf16(P[BASE + 6], P[BASE + 7]);                              \
    auto r0 = __builtin_amdgcn_permlane32_swap(a0, b0, false, false); auto r1 = __builtin_amdgcn_permlane32_swap(a1, b1, false, false); \
    u32x4 w = {r0[0], r1[0], r0[1], r1[1]}; OUT = *reinterpret_cast<bf16x8*>(&w); } while (0)
    PK4(p0, 0, pa0); PK4(p0, 8, pa1); PK4(p1, 0, pa2); PK4(p1, 8, pa3);
#undef PK4
}
__device__ __forceinline__ void qkt_(f32x16& p0, f32x16& p1, const char* Ks, const bf16x8* qr, int r32, int hi, int mapcol) {
    p0 = f32x16{}; p1 = f32x16{};
#pragma unroll
    for (int d0 = 0; d0 < 4; ++d0) { const int cb = mapcol + (d0 * 16 + hi * 8) * 2;
        const bf16x8 b0 = *reinterpret_cast<const bf16x8*>(Ks + KSWZ(r32, cb));
        const bf16x8 b1 = *reinterpret_cast<const bf16x8*>(Ks + KSWZ(32 + r32, cb));
        p0 = __builtin_amdgcn_mfma_f32_32x32x16_bf16(b0, qr[d0], p0, 0, 0, 0); p1 = __builtin_amdgcn_mfma_f32_32x32x16_bf16(b1, qr[d0], p1, 0, 0, 0); }
}
__device__ __forceinline__ int v_st(int k, int c) { const int kk = (k & ~0xC) | ((k & 4) << 1) | ((k & 8) >> 1); return ((kk >> 3) * 4 + (c >> 5)) * 512 + ((kk & 7) * 32 + (c & 31)) * 2; }
__device__ __forceinline__ int v_rd_base(int lane) { return ((lane & 3) << 3) | (((lane >> 2) & 3) << 6) | (((lane >> 4) & 1) << 5) | (((lane >> 5) & 1) << 8); }
constexpr int v_rd_off(int d0, int ks, int half) { return d0 * 512 + ks * 4096 + half * 2048; }
typedef short v4i16_t __attribute__((ext_vector_type(4)));
template <int OFF> __device__ __forceinline__ s16x4 tr_read(int vb) {
    return __builtin_bit_cast(s16x4, __builtin_amdgcn_ds_read_tr16_b64_v4i16((LAS v4i16_t*)(unsigned)(vb + OFF)));
}
struct VFrag { s16x4 l0, h0, l1, h1, l2, h2, l3, h3; };
template <int D0> __device__ __forceinline__ void v_reads(VFrag& f, int vb) {
    f.l0 = tr_read<v_rd_off(D0, 0, 0)>(vb); f.h0 = tr_read<v_rd_off(D0, 0, 1)>(vb); f.l1 = tr_read<v_rd_off(D0, 1, 0)>(vb); f.h1 = tr_read<v_rd_off(D0, 1, 1)>(vb);
    f.l2 = tr_read<v_rd_off(D0, 2, 0)>(vb); f.h2 = tr_read<v_rd_off(D0, 2, 1)>(vb); f.l3 = tr_read<v_rd_off(D0, 3, 0)>(vb); f.h3 = tr_read<v_rd_off(D0, 3, 1)>(vb);
}
__device__ __forceinline__ void pv_mma(f32x16& od, const VFrag& f, bf16x8 pa0, bf16x8 pa1, bf16x8 pa2, bf16x8 pa3) {
#define PK(L, H) (bf16x8){L[0], L[1], L[2], L[3], H[0], H[1], H[2], H[3]}
    od = __builtin_amdgcn_mfma_f32_32x32x16_bf16(pa0, PK(f.l0, f.h0), od, 0, 0, 0);
    od = __builtin_amdgcn_mfma_f32_32x32x16_bf16(pa1, PK(f.l1, f.h1), od, 0, 0, 0);
    od = __builtin_amdgcn_mfma_f32_32x32x16_bf16(pa2, PK(f.l2, f.h2), od, 0, 0, 0);
    od = __builtin_amdgcn_mfma_f32_32x32x16_bf16(pa3, PK(f.l3, f.h3), od, 0, 0, 0);
#undef PK
}
__device__ __forceinline__ void pv_d0_(f32x16* o, int vb, bf16x8 pa0, bf16x8 pa1, bf16x8 pa2, bf16x8 pa3) {
    VFrag fa, fb;
    v_reads<0>(fa, vb); v_reads<1>(fb, vb);
    __builtin_amdgcn_sched_group_barrier(0x100, 16, 0);
    pv_mma(o[0], fa, pa0, pa1, pa2, pa3);
    v_reads<2>(fa, vb); pv_mma(o[1], fb, pa0, pa1, pa2, pa3);
    v_reads<3>(fb, vb); pv_mma(o[2], fa, pa0, pa1, pa2, pa3);
    pv_mma(o[3], fb, pa0, pa1, pa2, pa3);
}
__device__ __forceinline__ void glds16(const void* gsrc, unsigned lds_dst) { unsigned keep;
    asm volatile("s_mov_b32 %0, m0\n\ts_mov_b32 m0, %2\n\ts_nop 0\n\tglobal_load_lds_dwordx4 %1, off\n\ts_mov_b32 m0, %0" : "=&s"(keep) : "v"(gsrc), "s"(lds_dst) : "memory"); }
template <int ABL>
__device__ __forceinline__ void attn_unit(const bf16_t* Qb, bf16_t* Ob, const bf16_t* __restrict__ Kh, const bf16_t* __restrict__ Vh, const float lam, const float shift2, const float* __restrict__ subg, char* lds, LAS unsigned char* ldsl) {
#define qkt(P0, P1, ...) do { if constexpr (ABL & 4) { P0 = f32x16{}; P1 = f32x16{}; asm volatile("" : "+v"(P0), "+v"(P1)); } else { attn::qkt_(P0, P1, __VA_ARGS__); } } while (0)
#define expA(P0) do { if constexpr (!(ABL & 2)) attn::expA_(P0); } while (0)
#define finishSM(...) attn::finishSM_<(ABL & 2) != 0>(__VA_ARGS__)
#define pv_d0(o, vb, a0, a1, a2, a3) do { if constexpr (ABL & 1) { asm volatile("" :: "v"(a0), "v"(a1), "v"(a2), "v"(a3)); } else { attn::pv_d0_(o, vb, a0, a1, a2, a3); } } while (0)
    int tid_ = threadIdx.x; asm volatile("" : "+v"(tid_));
    const int tid = tid_, wid = __builtin_amdgcn_readfirstlane(tid >> 6), lane = tid & 63, r32 = lane & 31, hi = lane >> 5, map = wid >> 2, wq = wid & 3;
    float l_reg = 0; f32x16 o[4] = {}; bf16x8 qr[4];
    const bf16_t* Qw = Qb + (size_t)(wq * 32 + r32) * 1024 + map * 64 + hi * 8;
#pragma unroll
    for (int d0 = 0; d0 < 4; ++d0) qr[d0] = *reinterpret_cast<const bf16x8*>(Qw + d0 * 16);
    const int mapcol = map * 128;
    const int vb0 = (int)(uintptr_t)lds + v_rd_base(lane);
    constexpr int SLOT = SHM_V + SHM_K;
    unsigned ksrc[2], vsrc[2];
#pragma unroll
    for (int i = 0; i < 2; ++i) {
        { const int row = 8 * wid + 4 * i + (lane >> 4), c = (lane & 15) ^ (row & 15); ksrc[i] = (unsigned)(row * 256 + c * 16); }
        { const int sub = 4 * wid + 2 * i + (lane >> 5), kk = (sub >> 2) * 8 + ((lane >> 2) & 7), key = (kk & ~0xC) | ((kk & 4) << 1) | ((kk & 8) >> 1), c = (sub & 3) * 32 + (lane & 3) * 8;
          vsrc[i] = (unsigned)(key * 256 + c * 2); }
    }
    const unsigned ldsw = (unsigned)wid * 2048u, lds0 = (unsigned)(uintptr_t)lds;
#define DMA(t) do { if constexpr (ABL & 8) break; const char* vt_ = (const char*)Vh + (size_t)(t) * (KVBLK * LDK * 2); const char* kt_ = (const char*)Kh + (size_t)(t) * (KVBLK * LDK * 2); const unsigned so_ = (unsigned)((t) & 3) * SLOT + ldsw; \
    _Pragma("unroll") for (int i_ = 0; i_ < 2; ++i_) { \
        glds16(vt_ + vsrc[i_], (unsigned)__builtin_amdgcn_readfirstlane((int)(lds0 + so_ + i_ * 1024))); \
        glds16(kt_ + ksrc[i_], (unsigned)__builtin_amdgcn_readfirstlane((int)(lds0 + so_ + SHM_V + i_ * 1024))); } } while (0)
#define WAITBAR(N) asm volatile("s_waitcnt vmcnt(" #N ") lgkmcnt(0)\n\ts_barrier" ::: "memory")
    f32x16 pA0, pA1, pB0, pB1; bf16x8 pa0, pa1, pa2, pa3; constexpr int NT = S / KVBLK;
#define SL(t) (((t) & 3) * SLOT)
    DMA(0); DMA(1); WAITBAR(4);
    if (map == 0) {
        DMA(2); qkt(pA0, pA1, lds + SHM_V, qr, r32, hi, mapcol); expA(pA0);
#pragma unroll 1
        for (int j = 1; j + 1 < NT; j += 2) {
            WAITBAR(4); if (j + 2 < NT) DMA(j + 2);
            qkt(pB0, pB1, lds + SL(j) + SHM_V, qr, r32, hi, mapcol);
            finishSM(pA0, pA1, l_reg, pa0, pa1, pa2, pa3);
            pv_d0(o, vb0 + SL(j - 1), pa0, pa1, pa2, pa3); expA(pB0);
            if (j + 3 < NT) { WAITBAR(4); DMA(j + 3); } else { WAITBAR(0); }
            qkt(pA0, pA1, lds + SL(j + 1) + SHM_V, qr, r32, hi, mapcol);
            finishSM(pB0, pB1, l_reg, pa0, pa1, pa2, pa3);
            pv_d0(o, vb0 + SL(j), pa0, pa1, pa2, pa3); expA(pA0);
        }
        WAITBAR(0);
        qkt(pB0, pB1, lds + SL(NT - 1) + SHM_V, qr, r32, hi, mapcol);
        finishSM(pA0, pA1, l_reg, pa0, pa1, pa2, pa3);
        pv_d0(o, vb0 + SL(NT - 2), pa0, pa1, pa2, pa3); expA(pB0);
        finishSM(pB0, pB1, l_reg, pa0, pa1, pa2, pa3);
        pv_d0(o, vb0 + SL(NT - 1), pa0, pa1, pa2, pa3);
    } else {
        DMA(2); qkt(pA0, pA1, lds + SHM_V, qr, r32, hi, mapcol); expA(pA0); finishSM(pA0, pA1, l_reg, pa0, pa1, pa2, pa3);
#pragma unroll 1
        for (int j = 1; j < NT; ++j) {
            if (j + 2 < NT) { WAITBAR(4); DMA(j + 2); } else { WAITBAR(0); }
            pv_d0(o, vb0 + SL(j - 1), pa0, pa1, pa2, pa3);
            qkt(pA0, pA1, lds + SL(j) + SHM_V, qr, r32, hi, mapcol); expA(pA0);
            finishSM(pA0, pA1, l_reg, pa0, pa1, pa2, pa3);
        }
        pv_d0(o, vb0 + SL(NT - 1), pa0, pa1, pa2, pa3);
    }
#undef SL
#undef DMA
#undef WAITBAR
    { auto rr = __builtin_amdgcn_permlane32_swap(__float_as_uint(l_reg), __float_as_uint(l_reg), false, false); l_reg = __uint_as_float(rr[0]) + __uint_as_float(rr[1]); }
    const int lane_e = (int)__builtin_amdgcn_mbcnt_hi(~0u, __builtin_amdgcn_mbcnt_lo(~0u, 0u)), r32e = lane_e & 31, hie = lane_e >> 5;
    float* wsf = (float*)(lds + XS_OFF) + wid * 64;
    if (hie == 0) wsf[r32e] = l_reg;
    asm volatile("s_waitcnt lgkmcnt(0)" ::: "memory");
    float rli[16];
#pragma unroll
    for (int r = 0; r < 16; ++r) rli[r] = __builtin_amdgcn_rcpf(wsf[crow(r, hie)]);
    __syncthreads();
    float* exch = (float*)lds + (size_t)wq * 4096 + lane_e;
    if (map == 1) {
#pragma unroll
        for (int r = 0; r < 16; ++r) { const float sc2 = lam * rli[r];
#pragma unroll
            for (int d0 = 0; d0 < 4; ++d0) exch[(r * 4 + d0) * 64] = o[d0][r] * sc2; }
    }
    __syncthreads();
    if (map == 0) {
        float sg[4];
#pragma unroll
        for (int d0 = 0; d0 < 4; ++d0) sg[d0] = subg[32 * d0 + r32e] * (1.f - LAM_INIT);
#pragma unroll
        for (int r = 0; r < 16; ++r) {
            float v[4]; float ss = 0.f;
#pragma unroll
            for (int d0 = 0; d0 < 4; ++d0) { v[d0] = o[d0][r] * rli[r] - exch[(r * 4 + d0) * 64]; ss += v[d0] * v[d0]; }
            ss += __shfl_xor(ss, 1); ss += __shfl_xor(ss, 2); ss += __shfl_xor(ss, 4); ss += __shfl_xor(ss, 8); ss += __shfl_xor(ss, 16);
            const float rstd = 1.f / sqrtf(ss * (1.f / 128.f) + EPS);
            bf16_t* srow = (bf16_t*)(lds + 65536 + wq * 8704 + crow(r, hie) * 272) + r32e;
#pragma unroll
            for (int d0 = 0; d0 < 4; ++d0) srow[32 * d0] = (bf16_t)f2bf(v[d0] * rstd * sg[d0]);
        }
        asm volatile("s_waitcnt lgkmcnt(0)" ::: "memory");
#pragma unroll
        for (int i = 0; i < 8; ++i) { const int row = 4 * i + (lane_e >> 4), ch = lane_e & 15;
            const u32x4 val = *(const u32x4*)(lds + 65536 + wq * 8704 + row * 272 + ch * 16);
            *(u32x4*)(Ob + (size_t)(wq * 32 + row) * 1024 + ch * 8) = val; }
    }
    __syncthreads();
#undef qkt
#undef expA
#undef finishSM
#undef pv_d0
}
#undef KSWZ
#undef SBAR
}

namespace hg {
typedef short v4i16_t __attribute__((ext_vector_type(4)));
constexpr int PITCH = 288, APITCH = 160;
constexpr int OFF_QT = 0, OFF_KT = 64 * PITCH, OFF_VV = 2 * 64 * PITCH, OFF_ASC = 3 * 64 * PITCH, OFF_OB = OFF_ASC + 64 * APITCH, OFF_TOT = OFF_OB + 64 * PITCH, OFF_C1 = OFF_TOT + 4096, OFF_C2 = OFF_C1 + 512, OFF_D = OFF_C2 + 512, OFF_VV2 = OFF_D + 512, OFF_QST = OFF_VV2 + 64 * PITCH, OFF_END = OFF_QST + 512 * 32;
static_assert(OFF_END <= RING_BYTES, "hgrn LDS");
__device__ __forceinline__ bf16x8 trpair(const LAS unsigned char* p) {
    const s16x4 lo = __builtin_bit_cast(s16x4, __builtin_amdgcn_ds_read_tr16_b64_v4i16((LAS v4i16_t*)p));
    const s16x4 hi = __builtin_bit_cast(s16x4, __builtin_amdgcn_ds_read_tr16_b64_v4i16((LAS v4i16_t*)(p + 8 * PITCH)));
    return (bf16x8){lo[0], lo[1], lo[2], lo[3], hi[0], hi[1], hi[2], hi[3]};
}
__device__ __forceinline__ int prow(int t) { return (t & ~12) | ((t & 4) << 1) | ((t & 8) >> 1); }
constexpr int QPITCH = 272;
struct HgRegs { u32x4 ga, gb, qa, qb, va, vb; };
struct HgG { u32x4 ga, gb; };
#define HG_ROW(p) ((dir == 0) ? (p) : ((p) < LC ? (LC - 1 - (p)) : (S + LC - 1 - (p))))
template <int ABL>
__device__ __forceinline__ void hg_prefetch(HgRegs& R, const int c, const int dir, const int t0, const int oc, const unsigned short* G, const unsigned short* I, const unsigned short* QH) {
    if constexpr (ABL & 4) return;
    const int r0 = HG_ROW(c * 64 + t0), r1 = HG_ROW(c * 64 + t0 + 1);
    R.ga = __builtin_nontemporal_load((const u32x4*)(G + (size_t)r0 * 128 + 8 * oc)); R.gb = __builtin_nontemporal_load((const u32x4*)(G + (size_t)r1 * 128 + 8 * oc));
    R.va = __builtin_nontemporal_load((const u32x4*)(I + (size_t)r0 * 128 + 8 * oc)); R.vb = __builtin_nontemporal_load((const u32x4*)(I + (size_t)r1 * 128 + 8 * oc));
    { const int q0 = c >= LC / 64 ? r0 - LC : 0, q1 = c >= LC / 64 ? r1 - LC : 0;
      R.qa = __builtin_nontemporal_load((const u32x4*)(QH + (size_t)q0 * 128 + 8 * oc)); R.qb = __builtin_nontemporal_load((const u32x4*)(QH + (size_t)q1 * 128 + 8 * oc)); }
}
#define HG_BAR() asm volatile("s_waitcnt lgkmcnt(0)\n\ts_barrier" ::: "memory")
__device__ __forceinline__ void hg_prefix(const HgG& R, float (&inc)[8], float (&ex)[8], const int lg) {
#pragma unroll
    for (int ep = 0; ep < 4; ++ep) {
#pragma unroll
        for (int hh = 0; hh < 2; ++hh) { const int e = 2 * ep + hh;
            const float s = (hh ? f16hi(R.ga[ep]) : f16lo(R.ga[ep])) + (hh ? f16hi(R.gb[ep]) : f16lo(R.gb[ep]));
            const float p1 = __builtin_bit_cast(float, __builtin_amdgcn_mov_dpp(__builtin_bit_cast(int, s), 0x90, 0xf, 0xf, false));
            const float s2 = (lg >= 1) ? s + p1 : s;
            const float p2 = __builtin_bit_cast(float, __builtin_amdgcn_mov_dpp(__builtin_bit_cast(int, s2), 0x44, 0xf, 0xf, false));
            inc[e] = (lg >= 2) ? s2 + p2 : s2; ex[e] = inc[e] - s; } }
}
__device__ __forceinline__ void hg_e1(const HgG& R, LAS unsigned char* lds, const int w, const int oc, const int lg) {
    float inc[8], ex[8]; hg_prefix(R, inc, ex, lg);
    if (lg == 3) { *(LAS f32x4*)(lds + OFF_TOT + (w * 128 + 8 * oc) * 4) = (f32x4){inc[0], inc[1], inc[2], inc[3]}; *(LAS f32x4*)(lds + OFF_TOT + (w * 128 + 8 * oc + 4) * 4) = (f32x4){inc[4], inc[5], inc[6], inc[7]}; }
}
__device__ __forceinline__ void hg_e2(const HgG& R, LAS unsigned char* lds, const int tid, const int w, const int oc, const int lg, const int t0) {
    float inc[8], ex[8]; hg_prefix(R, inc, ex, lg);
    const u32x4 qa = *(const LAS u32x4*)(lds + OFF_QST + tid * 32), qb = *(const LAS u32x4*)(lds + OFF_QST + tid * 32 + 16);
    u32x4 oq0, oq1, ok0, ok1;
#pragma unroll
    for (int ep = 0; ep < 4; ++ep) {
        float cum0 = 0.f, cum1 = 0.f, off0 = 0.f, off1 = 0.f, bm0 = 0.f, bm1 = 0.f;
#pragma unroll
        for (int k = 0; k < 8; ++k) { const f32x2 t = *(const LAS f32x2*)(lds + OFF_TOT + (k * 128 + 8 * oc + 2 * ep) * 4);
            if (k == w) { off0 = cum0; off1 = cum1; } cum0 += t.x; cum1 += t.y; if (k == 3) { bm0 = cum0; bm1 = cum1; } }
        const float xa0 = f16lo(R.ga[ep]), xa1 = f16hi(R.ga[ep]), xb0 = f16lo(R.gb[ep]), xb1 = f16hi(R.gb[ep]);
        const float ba0 = off0 + ex[2 * ep] + xa0, ba1 = off1 + ex[2 * ep + 1] + xa1, bb0 = ba0 + xb0, bb1 = ba1 + xb1;
        const float eaa0 = __builtin_amdgcn_exp2f(fminf(ba0 - bm0, 80.f) * LOG2E), eaa1 = __builtin_amdgcn_exp2f(fminf(ba1 - bm1, 80.f) * LOG2E);
        const float eab0 = __builtin_amdgcn_exp2f(fminf(bb0 - bm0, 80.f) * LOG2E), eab1 = __builtin_amdgcn_exp2f(fminf(bb1 - bm1, 80.f) * LOG2E);
        const float eba0 = __builtin_amdgcn_exp2f(fminf(bm0 - ba0, 80.f) * LOG2E), eba1 = __builtin_amdgcn_exp2f(fminf(bm1 - ba1, 80.f) * LOG2E);
        const float ebb0 = __builtin_amdgcn_exp2f(fminf(bm0 - bb0, 80.f) * LOG2E), ebb1 = __builtin_amdgcn_exp2f(fminf(bm1 - bb1, 80.f) * LOG2E);
        const float ka0 = 1.f - __builtin_amdgcn_exp2f(xa0 * LOG2E), ka1 = 1.f - __builtin_amdgcn_exp2f(xa1 * LOG2E), kb0 = 1.f - __builtin_amdgcn_exp2f(xb0 * LOG2E), kb1 = 1.f - __builtin_amdgcn_exp2f(xb1 * LOG2E);
        oq0[ep] = cvt_pk_bf16(bflo(qa[ep]) * eaa0, bfhi(qa[ep]) * eaa1); oq1[ep] = cvt_pk_bf16(bflo(qb[ep]) * eab0, bfhi(qb[ep]) * eab1);
        ok0[ep] = cvt_pk_bf16(ka0 * eba0, ka1 * eba1); ok1[ep] = cvt_pk_bf16(kb0 * ebb0, kb1 * ebb1);
        if (w == 0 && lg == 0) {
            *(LAS f32x2*)(lds + OFF_C1 + (8 * oc + 2 * ep) * 4) = (f32x2){__builtin_amdgcn_exp2f(bm0 * LOG2E), __builtin_amdgcn_exp2f(bm1 * LOG2E)};
            *(LAS f32x2*)(lds + OFF_C2 + (8 * oc + 2 * ep) * 4) = (f32x2){__builtin_amdgcn_exp2f((cum0 - bm0) * LOG2E), __builtin_amdgcn_exp2f((cum1 - bm1) * LOG2E)};
            *(LAS f32x2*)(lds + OFF_D + (8 * oc + 2 * ep) * 4) = (f32x2){__builtin_amdgcn_exp2f(cum0 * LOG2E), __builtin_amdgcn_exp2f(cum1 * LOG2E)}; }
        __builtin_amdgcn_sched_barrier(0); }
    const int pt0 = prow(t0);
    *(LAS u32x4*)(lds + OFF_QT + t0 * QPITCH + 16 * oc) = oq0; *(LAS u32x4*)(lds + OFF_QT + (t0 + 1) * QPITCH + 16 * oc) = oq1;
    *(LAS u32x4*)(lds + OFF_KT + pt0 * PITCH + 16 * oc) = ok0; *(LAS u32x4*)(lds + OFF_KT + (pt0 + 1) * PITCH + 16 * oc) = ok1;
}
__device__ __forceinline__ unsigned hg_logf2(unsigned w, float lb0, float lb1) {
    return pk_f16(__logf(lb0 + (1.f - lb0) * sigmoidf_(f16lo(w))), __logf(lb1 + (1.f - lb1) * sigmoidf_(f16hi(w))));
}
__device__ __forceinline__ void hg_stash(const HgRegs& RN, HgG& R, const int cn, LAS unsigned char* lds, const int tid, const int oc, const int t0, const float* lbh) {
    const int pt0 = prow(t0), vv = (cn & 1) ? OFF_VV2 : OFF_VV;
    { const f32x4 l0 = *(const f32x4*)(lbh + 8 * oc), l1 = *(const f32x4*)(lbh + 8 * oc + 4);
      R.ga.x = hg_logf2(RN.ga.x, l0[0], l0[1]); R.ga.y = hg_logf2(RN.ga.y, l0[2], l0[3]); R.ga.z = hg_logf2(RN.ga.z, l1[0], l1[1]); R.ga.w = hg_logf2(RN.ga.w, l1[2], l1[3]);
      R.gb.x = hg_logf2(RN.gb.x, l0[0], l0[1]); R.gb.y = hg_logf2(RN.gb.y, l0[2], l0[3]); R.gb.z = hg_logf2(RN.gb.z, l1[0], l1[1]); R.gb.w = hg_logf2(RN.gb.w, l1[2], l1[3]); }
    *(LAS u32x4*)(lds + vv + pt0 * PITCH + 16 * oc) = RN.va; *(LAS u32x4*)(lds + vv + (pt0 + 1) * PITCH + 16 * oc) = RN.vb;
    *(LAS u32x4*)(lds + OFF_QST + tid * 32) = RN.qa; *(LAS u32x4*)(lds + OFF_QST + tid * 32 + 16) = RN.qb;
}
template <int ABL>
__device__ __forceinline__ void hg_chunk(const int c, HgG& R, f32x4 (&St)[8], const int b, const int h, const int dir, unsigned short* G, const unsigned short* I, const unsigned short* QH, unsigned short* scratch, LAS unsigned char* lds,
                                         const int w, const int lane_in, const float* lbh) {
    const bool lat = c >= LC / 64, more = c + 1 < S / 64;
    int lane = lane_in; asm volatile("" : "+v"(lane));
    int l15 = lane & 15, g = lane >> 4, q4 = l15 >> 2, p4 = lane & 3, oc = lane >> 2, lg = lane & 3, t0 = 2 * (4 * w + lg), tid = w * 64 + lane;
    HgRegs RN;
    if (c + 2 < S / 64) hg_prefetch<ABL>(RN, c + 2, dir, t0, oc, G, I, QH);
    if (more) hg_e1(R, lds, w, oc, lg);
    f32x4 o[4];
    const int trb = ((g >> 1) * 16 + (g & 1) * 4 + q4) * PITCH;
    if (lat) {
#pragma unroll 1
        for (int n = w; n < 10; n += 8) {
            const int ti = (n >= 6) ? 3 : (n >= 3) ? 2 : (n >= 1) ? 1 : 0, sj = n - (ti * (ti + 1)) / 2;
            bf16x8 ka[4], qb[4];
#pragma unroll
            for (int ks = 0; ks < 4; ++ks) { ka[ks] = *(const LAS bf16x8*)(lds + OFF_KT + (16 * sj + prow(l15)) * PITCH + (32 * ks + 8 * g) * 2); qb[ks] = *(const LAS bf16x8*)(lds + OFF_QT + (16 * ti + l15) * QPITCH + (32 * ks + 8 * g) * 2); }
            f32x4 a = (f32x4){0.f, 0.f, 0.f, 0.f};
#pragma unroll
            for (int ks = 0; ks < 4; ++ks) a = __builtin_amdgcn_mfma_f32_16x16x32_bf16(ka[ks], qb[ks], a, 0, 0, 0);
            if (sj == ti) {
#pragma unroll
                for (int r = 0; r < 4; ++r) if (4 * g + r > l15) a[r] = 0.f; }
            u32x2 pw; pw.x = cvt_pk_bf16(a[0], a[1]); pw.y = cvt_pk_bf16(a[2], a[3]);
            *(LAS u32x2*)(lds + OFF_ASC + (16 * ti + l15) * APITCH + (16 * sj + 4 * g) * 2) = pw;
        }
#define HG_LOADA(ks_, dst) do { _Pragma("unroll") for (int ti = 0; ti < 4; ++ti) { \
            const u32x2 alo_ = *(const LAS u32x2*)(lds + OFF_QT + (16 * ti + l15) * QPITCH + (32 * (ks_) + 4 * g) * 2), ahi_ = *(const LAS u32x2*)(lds + OFF_QT + (16 * ti + l15) * QPITCH + (32 * (ks_) + 16 + 4 * g) * 2); \
            dst[ti] = (u32x4){alo_.x, alo_.y, ahi_.x, ahi_.y}; } } while (0)
#pragma unroll
        for (int ks = 0; ks < 4; ++ks) {
            const f32x4 ca = *(const LAS f32x4*)(lds + OFF_C1 + (32 * ks + 4 * g) * 4), cb = *(const LAS f32x4*)(lds + OFF_C1 + (32 * ks + 16 + 4 * g) * 4);
            u32x4 aw[4];
            HG_LOADA(ks, aw);
            const f32x4 sa = St[2 * ks] * ca, sb = St[2 * ks + 1] * cb;
            u32x4 bw; bw.x = cvt_pk_bf16(sa[0], sa[1]); bw.y = cvt_pk_bf16(sa[2], sa[3]); bw.z = cvt_pk_bf16(sb[0], sb[1]); bw.w = cvt_pk_bf16(sb[2], sb[3]);
            const bf16x8 bs = __builtin_bit_cast(bf16x8, bw);
#pragma unroll
            for (int ti = 0; ti < 4; ++ti) o[ti] = __builtin_amdgcn_mfma_f32_16x16x32_bf16(__builtin_bit_cast(bf16x8, aw[ti]), bs, ks == 0 ? (f32x4){0.f, 0.f, 0.f, 0.f} : o[ti], 0, 0, 0);
        }
#undef HG_LOADA
    }
    bf16x8 vf[2];
#pragma unroll
    for (int kk = 0; kk < 2; ++kk) vf[kk] = trpair(lds + ((c & 1) ? OFF_VV2 : OFF_VV) + 32 * kk * PITCH + trb + (16 * w + 4 * p4) * 2);
#pragma unroll
    for (int blk = 0; blk < 8; ++blk) {
        f32x4 tt = (f32x4){0.f, 0.f, 0.f, 0.f};
#pragma unroll
        for (int kk = 0; kk < 2; ++kk) { const bf16x8 ka = trpair(lds + OFF_KT + 32 * kk * PITCH + trb + (16 * blk + 4 * p4) * 2);
            tt = __builtin_amdgcn_mfma_f32_16x16x32_bf16(ka, vf[kk], tt, 0, 0, 0); }
        const f32x4 dd = *(const LAS f32x4*)(lds + OFF_D + (16 * blk + 4 * g) * 4), cc = *(const LAS f32x4*)(lds + OFF_C2 + (16 * blk + 4 * g) * 4);
        St[blk] = dd * St[blk] + cc * tt;
        if (blk == 3) __builtin_amdgcn_sched_barrier(0);
    }
    asm volatile("s_waitcnt lgkmcnt(0)\n\ts_barrier" : "+v"(St[0]), "+v"(St[1]), "+v"(St[2]), "+v"(St[3]), "+v"(St[4]), "+v"(St[5]), "+v"(St[6]), "+v"(St[7]) :: "memory");
    lane = lane_in; asm volatile("" : "+v"(lane));
    l15 = lane & 15; g = lane >> 4; q4 = l15 >> 2; p4 = lane & 3; oc = lane >> 2; lg = lane & 3; t0 = 2 * (4 * w + lg); tid = w * 64 + lane;
    const int vrow = tid >> 3, vpc = tid & 7;
    if (more) hg_e2(R, lds, tid, w, oc, lg, t0);
    if (lat) {
        bf16x8 af[6];
        af[0] = *(const LAS bf16x8*)(lds + OFF_ASC + (l15) * APITCH + (8 * g) * 2); af[1] = *(const LAS bf16x8*)(lds + OFF_ASC + (16 + l15) * APITCH + (8 * g) * 2);
        af[2] = *(const LAS bf16x8*)(lds + OFF_ASC + (32 + l15) * APITCH + (8 * g) * 2); af[3] = *(const LAS bf16x8*)(lds + OFF_ASC + (32 + l15) * APITCH + (32 + 8 * g) * 2);
        af[4] = *(const LAS bf16x8*)(lds + OFF_ASC + (48 + l15) * APITCH + (8 * g) * 2); af[5] = *(const LAS bf16x8*)(lds + OFF_ASC + (48 + l15) * APITCH + (32 + 8 * g) * 2);
        o[0] = __builtin_amdgcn_mfma_f32_16x16x32_bf16(af[0], vf[0], o[0], 0, 0, 0); o[1] = __builtin_amdgcn_mfma_f32_16x16x32_bf16(af[1], vf[0], o[1], 0, 0, 0);
        o[2] = __builtin_amdgcn_mfma_f32_16x16x32_bf16(af[2], vf[0], o[2], 0, 0, 0); o[3] = __builtin_amdgcn_mfma_f32_16x16x32_bf16(af[4], vf[0], o[3], 0, 0, 0);
        o[2] = __builtin_amdgcn_mfma_f32_16x16x32_bf16(af[3], vf[1], o[2], 0, 0, 0); o[3] = __builtin_amdgcn_mfma_f32_16x16x32_bf16(af[5], vf[1], o[3], 0, 0, 0);
#pragma unroll
        for (int ti = 0; ti < 4; ++ti)
#pragma unroll
            for (int r = 0; r < 4; ++r) *(LAS unsigned short*)(lds + OFF_OB + (16 * ti + 4 * g + r) * PITCH + (16 * w + l15) * 2) = (unsigned short)f2bf(o[ti][r]);
    }
    HG_BAR();
    if (c + 2 < S / 64) hg_stash(RN, R, c + 2, lds, tid, oc, t0, lbh);
    if (lat) { const int r_ = HG_ROW(c * 64 + vrow); u32x4* d_ = scratch ? (u32x4*)(scratch + ((size_t)b * T + (r_ - LC)) * 1024 + h * 128 + vpc * 16) : (u32x4*)(G + (size_t)r_ * 128 + vpc * 16);
        __builtin_nontemporal_store(*(const LAS u32x4*)(lds + OFF_OB + vrow * PITCH + vpc * 32), d_); __builtin_nontemporal_store(*(const LAS u32x4*)(lds + OFF_OB + vrow * PITCH + vpc * 32 + 16), d_ + 1); }
}
template <int ABL>
__device__ __forceinline__ void hgrn_unit(const int b, const int h, const int dir, unsigned char* ws, LAS unsigned char* lds, unsigned short* scratch) {
    int tid_ = threadIdx.x; asm volatile("" : "+v"(tid_));
    const int tid = tid_, w = __builtin_amdgcn_readfirstlane(tid >> 6), lane = tid & 63, l15 = lane & 15, g = lane >> 4, q4 = l15 >> 2, p4 = lane & 3;
    unsigned short* G = (unsigned short*)(ws + (dir == 0 ? WS_GF : WS_GB)) + (size_t)(b * NH + h) * S * 128;
    const unsigned short* I = (const unsigned short*)(ws + WS_IALL) + (size_t)(b * NH + h) * S * 128;
    const unsigned short* QH = (const unsigned short*)(ws + WS_QH) + (size_t)(b * NH + h) * T * 128;
    const float* lbh = (const float*)(ws + WS_PAR) + (dir == 0 ? PAR_LBF : PAR_LBB) + h * 128;
    f32x4 St[8];
#pragma unroll
    for (int k = 0; k < 8; ++k) St[k] = (f32x4){0.f, 0.f, 0.f, 0.f};
    { unsigned z = 0u; asm volatile("" : "+v"(z));
      for (int i = tid; i < 64 * APITCH / 16; i += 512) *(LAS u32x4*)(lds + OFF_ASC + i * 16) = (u32x4){z, z, z, z}; }
    const int oc = lane >> 2, lg = lane & 3, t0 = 2 * (4 * w + lg);
    HgRegs RA, RB;
    hg_prefetch<ABL>(RA, 0, dir, t0, oc, G, I, QH); hg_prefetch<ABL>(RB, 1, dir, t0, oc, G, I, QH);
    __syncthreads();
    HgG R;
    hg_stash(RA, R, 0, lds, tid, oc, t0, lbh);
    hg_e1(R, lds, w, oc, lg); HG_BAR(); hg_e2(R, lds, tid, w, oc, lg, t0); HG_BAR();
    hg_stash(RB, R, 1, lds, tid, oc, t0, lbh);
#pragma unroll 1
    for (int c = 0; c < S / 64; ++c) hg_chunk<ABL>(c, R, St, b, h, dir, G, I, QH, scratch, lds, w, lane, lbh);
    __syncthreads();
}
#undef HG_ROW
}


struct SchedZ {
    int G, c; const char* H; const char* W;
    __device__ __forceinline__ bool next(int i, pg8::Unit& u) const {
        const int L = i * G + c; if (L >= 128 * 12) return false;
        pg8::tile_map(L, 128, 12, u.pm, u.pn); if (u.pn >= 8) u.pn += 4;
        u.kind = 0; u.A = H + (size_t)u.pm * (256 * 1024 * 2); u.B = W + (size_t)u.pn * (256 * 1024 * 2); return true;
    }
};
struct EpiZ {
    static constexpr bool PERM = true, MID = false;
    unsigned char* ws; const float* hgain; LAS unsigned char* lds; unsigned char* outb;
    __device__ __forceinline__ void operator()(const f32x4 (&acc)[2][2][4][2], const pg8::Unit& u, int wr, int wc, int fr, int fq) const {
        const int grp = u.pn >> 2, cg0 = (u.pn & 3) * 256 + wc * 32 + 8 * fq;
        bf16_t* dst = (grp == 2 ? (bf16_t*)(outb + OUT_GA) : (bf16_t*)(ws + (grp < 2 ? WS_YA : WS_GH))) + (grp == 1 ? 1024 : 0); const int dp = grp < 2 ? 2048 : 1024;
        const int row0 = u.pm * 256 + wr * 64 + fr;
        if (grp == 1) {
            const size_t hb = ((size_t)((u.pm >> 4) * NH + (u.pn & 3) * 2) * S + LC + (u.pm & 15) * 256 + wr * 64 + fr) * 128 + wc * 32 + 8 * fq;
            const bf16_t* of = (const bf16_t*)(ws + WS_GF) + hb; const bf16_t* ob = (const bf16_t*)(ws + WS_GB) + hb;
            LAS float* xs = (LAS float*)(lds + XS_OFF);
#pragma unroll
            for (int ai = 0; ai < 2; ++ai)
#pragma unroll
                for (int m = 0; m < 4; ++m)
#pragma unroll
                    for (int bj = 0; bj < 2; ++bj) { const size_t o_ = (size_t)(ai * 128 + m * 16) * 128 + (size_t)bj * S * 128;
                        const u32x4 a = *(const u32x4*)(of + o_), b = *(const u32x4*)(ob + o_);
                        const float s0 = bflo(a.x) + bflo(b.x), s1 = bfhi(a.x) + bfhi(b.x), s2 = bflo(a.y) + bflo(b.y), s3 = bfhi(a.y) + bfhi(b.y), s4 = bflo(a.z) + bflo(b.z), s5 = bfhi(a.z) + bfhi(b.z), s6 = bflo(a.w) + bflo(b.w), s7 = bfhi(a.w) + bfhi(b.w);
                        float ss = (s0 * s0 + s1 * s1) + (s2 * s2 + s3 * s3) + (s4 * s4 + s5 * s5) + (s6 * s6 + s7 * s7);
                        ss += __shfl_xor(ss, 16); ss += __shfl_xor(ss, 32);
                        if (fq == 0) xs[((ai * 128 + wr * 64 + m * 16 + fr) * 2 + bj) * 4 + wc] = ss; }
            asm volatile("s_waitcnt lgkmcnt(0)" ::: "memory"); __builtin_amdgcn_s_barrier(); asm volatile("" ::: "memory");
            const f32x4 g0 = *(const f32x4*)(hgain + wc * 32 + 8 * fq), g1 = *(const f32x4*)(hgain + wc * 32 + 8 * fq + 4);
#pragma unroll
            for (int ai = 0; ai < 2; ++ai)
#pragma unroll
                for (int m = 0; m < 4; ++m) { const size_t off = (size_t)(row0 + ai * 128 + m * 16) * dp + cg0;
#pragma unroll
                    for (int bj = 0; bj < 2; ++bj) { const size_t o_ = (size_t)(ai * 128 + m * 16) * 128 + (size_t)bj * S * 128;
                        const f32x4 p = *(const LAS f32x4*)(xs + ((ai * 128 + wr * 64 + m * 16 + fr) * 2 + bj) * 4);
                        const float rstd = 1.f / sqrtf(((p[0] + p[1]) + (p[2] + p[3])) * (1.f / 128.f) + EPS);
                        const u32x4 a = *(const u32x4*)(of + o_), b = *(const u32x4*)(ob + o_);
                        const f32x4 v0 = acc[ai][bj][m][0], v1 = acc[ai][bj][m][1];
                        const float y0 = (bflo(a.x) + bflo(b.x)) * rstd * g0[0] * siluf_(v0[0]), y1 = (bfhi(a.x) + bfhi(b.x)) * rstd * g0[1] * siluf_(v0[1]);
                        const float y2 = (bflo(a.y) + bflo(b.y)) * rstd * g0[2] * siluf_(v0[2]), y3 = (bfhi(a.y) + bfhi(b.y)) * rstd * g0[3] * siluf_(v0[3]);
                        const float y4 = (bflo(a.z) + bflo(b.z)) * rstd * g1[0] * siluf_(v1[0]), y5 = (bfhi(a.z) + bfhi(b.z)) * rstd * g1[1] * siluf_(v1[1]);
                        const float y6 = (bflo(a.w) + bflo(b.w)) * rstd * g1[2] * siluf_(v1[2]), y7 = (bfhi(a.w) + bfhi(b.w)) * rstd * g1[3] * siluf_(v1[3]);
                        u32x4 w; w.x = cvt_pk_bf16(y0, y1); w.y = cvt_pk_bf16(y2, y3); w.z = cvt_pk_bf16(y4, y5); w.w = cvt_pk_bf16(y6, y7);
                        *(u32x4*)(dst + off + bj * 128) = w; } }
            return;
        }
        const bf16_t* src = (const bf16_t*)(ws + WS_Q);
#pragma unroll
        for (int ai = 0; ai < 2; ++ai)
#pragma unroll
            for (int m = 0; m < 4; ++m) { const size_t ioff = (size_t)(row0 + ai * 128 + m * 16) * 1024 + cg0, off = (size_t)(row0 + ai * 128 + m * 16) * dp + cg0;
#pragma unroll
                for (int bj = 0; bj < 2; ++bj) { f32x4 v0 = acc[ai][bj][m][0], v1 = acc[ai][bj][m][1];
                    if (grp == 0) { const u32x4 s = *(const u32x4*)(src + ioff + bj * 128);
                        v0[0] = siluf_(v0[0]) * bflo(s.x); v0[1] = siluf_(v0[1]) * bfhi(s.x); v0[2] = siluf_(v0[2]) * bflo(s.y); v0[3] = siluf_(v0[3]) * bfhi(s.y);
                        v1[0] = siluf_(v1[0]) * bflo(s.z); v1[1] = siluf_(v1[1]) * bfhi(s.z); v1[2] = siluf_(v1[2]) * bflo(s.w); v1[3] = siluf_(v1[3]) * bfhi(s.w);
                    } else {
#pragma unroll
                        for (int e = 0; e < 4; ++e) { v0[e] = sigmoidf_(v0[e]); v1[e] = sigmoidf_(v1[e]); }
                    }
                    u32x4 w; w.x = cvt_pk_bf16(v0[0], v0[1]); w.y = cvt_pk_bf16(v0[2], v0[3]); w.z = cvt_pk_bf16(v1[0], v1[1]); w.w = cvt_pk_bf16(v1[2], v1[3]);
                    *(u32x4*)(dst + off + bj * 128) = w; } }
    }
};
struct SchedOne {
    int pm, pn; const char* H; const char* W;
    __device__ __forceinline__ bool next(int i, pg8::Unit& u) const {
        if (i > 1) return false;
        u.pm = pm; u.pn = pn + i; u.kind = 0; u.A = H + (size_t)pm * (256 * 1024 * 2); u.B = W + (size_t)(pn + i) * (256 * 1024 * 2); return true;
    }
};
struct SchedM {
    int G, c; const char* Y; const char* WB;
    __device__ __forceinline__ bool next(int i, pg8::Unit& u) const {
        const int tile = i * G + c; if (tile >= 128 * 4) return false;
        pg8::tile_map(tile, 128, 4, u.pm, u.pn); u.kind = 0;
        u.A = Y + (size_t)u.pm * (256 * 2048 * 2); u.B = WB + (size_t)u.pn * (256 * 2048 * 2); return true;
    }
};
struct EpiM {
    static constexpr bool PERM = true, MID = true;
    unsigned char* ws; unsigned char* outb;
    __device__ __forceinline__ void mid(f32x4 (&acc)[2][2][4][2], const pg8::Unit& u, int wr, int wc, int fr, int fq) const {
        const size_t ubo = ((size_t)(u.pm * 256 + wr * 64) * 1024 + u.pn * 256 + wc * 32) * 2; unsigned loff = (unsigned)(fr * 1024 + 8 * fq) * 2u;
        asm volatile("" : "+v"(loff));
        const unsigned char* ga = outb + OUT_GA + ubo; const unsigned char* gh = ws + WS_GH + ubo;
#pragma unroll
        for (int ai = 0; ai < 2; ++ai)
#pragma unroll
            for (int m = 0; m < 4; ++m) { const unsigned char* gar = ga + (size_t)((ai * 128 + m * 16) * 2048); const unsigned char* ghr = gh + (size_t)((ai * 128 + m * 16) * 2048);
#pragma unroll
                for (int bj = 0; bj < 2; ++bj) { const u32x4 a = *(const u32x4*)(gar + bj * 256 + loff), h = *(const u32x4*)(ghr + bj * 256 + loff);
                    f32x4& v0 = acc[ai][bj][m][0]; f32x4& v1 = acc[ai][bj][m][1];
                    v0[0] *= bflo(a.x) * __builtin_amdgcn_rcpf(bflo(h.x)); v0[1] *= bfhi(a.x) * __builtin_amdgcn_rcpf(bfhi(h.x)); v0[2] *= bflo(a.y) * __builtin_amdgcn_rcpf(bflo(h.y)); v0[3] *= bfhi(a.y) * __builtin_amdgcn_rcpf(bfhi(h.y));
                    v1[0] *= bflo(a.z) * __builtin_amdgcn_rcpf(bflo(h.z)); v1[1] *= bfhi(a.z) * __builtin_amdgcn_rcpf(bfhi(h.z)); v1[2] *= bflo(a.w) * __builtin_amdgcn_rcpf(bflo(h.w)); v1[3] *= bfhi(a.w) * __builtin_amdgcn_rcpf(bfhi(h.w)); }
                asm volatile("" ::: "memory"); }
    }
    __device__ __forceinline__ void operator()(const f32x4 (&acc)[2][2][4][2], const pg8::Unit& u, int wr, int wc, int fr, int fq) const {
        const size_t ubo = ((size_t)(u.pm * 256 + wr * 64) * 1024 + u.pn * 256 + wc * 32) * 2; unsigned loff = (unsigned)(fr * 1024 + 8 * fq) * 2u;
        asm volatile("" : "+v"(loff));
        const unsigned char* gate = ws + WS_GH + ubo; unsigned char* mm = ws + WS_MM + ubo;
#pragma unroll
        for (int ai = 0; ai < 2; ++ai)
#pragma unroll
            for (int m = 0; m < 4; ++m) { const unsigned char* gr = gate + (size_t)((ai * 128 + m * 16) * 2048); unsigned char* mr = mm + (size_t)((ai * 128 + m * 16) * 2048);
#pragma unroll
                for (int bj = 0; bj < 2; ++bj) { f32x4 v0 = acc[ai][bj][m][0], v1 = acc[ai][bj][m][1]; const u32x4 g = *(const u32x4*)(gr + bj * 256 + loff);
                    v0[0] *= bflo(g.x); v0[1] *= bfhi(g.x); v0[2] *= bflo(g.y); v0[3] *= bfhi(g.y); v1[0] *= bflo(g.z); v1[1] *= bfhi(g.z); v1[2] *= bflo(g.w); v1[3] *= bfhi(g.w);
                    u32x4 w; w.x = cvt_pk_bf16(v0[0], v0[1]); w.y = cvt_pk_bf16(v0[2], v0[3]); w.z = cvt_pk_bf16(v1[0], v1[1]); w.w = cvt_pk_bf16(v1[2], v1[3]);
                    *(u32x4*)(mr + bj * 256 + loff) = w; } }
    }
};
struct SchedO {
    int G, c; const char* MMp; const char* W;
    __device__ __forceinline__ bool next(int i, pg8::Unit& u) const {
        const int L = i * G + c; if (L >= 128 * 4) return false;
        pg8::tile_map(L, 128, 4, u.pm, u.pn); u.kind = 0; u.A = MMp + (size_t)u.pm * (256 * 1024 * 2); u.B = W + (size_t)u.pn * (256 * 1024 * 2); return true;
    }
};
struct EpiOut {
    static constexpr bool PERM = false, MID = false;
    const float* x; float* out; const float* par;
    __device__ __forceinline__ void operator()(const f32x4 (&acc)[2][2][4][2], const pg8::Unit& u, int wr, int wc, int fr, int fq) const {
        const int row0 = u.pm * 256 + wr * 64 + fr, col0 = u.pn * 256 + wc * 32 + 4 * fq;
        const float* gp = par + PAR_MOD + (u.pm >> 4) * 3072 + 2048 + col0;
        f32x4 gv[2][2];
#pragma unroll
        for (int bj = 0; bj < 2; ++bj)
#pragma unroll
            for (int n = 0; n < 2; ++n) gv[bj][n] = *(const f32x4*)(gp + bj * 128 + n * 16);
#pragma unroll
        for (int ai = 0; ai < 2; ++ai)
#pragma unroll
            for (int m = 0; m < 4; ++m) { const size_t off = (size_t)(row0 + ai * 128 + m * 16) * 1024 + col0;
#pragma unroll
                for (int bj = 0; bj < 2; ++bj)
#pragma unroll
                    for (int n = 0; n < 2; ++n) { const f32x4 xv = *(const f32x4*)(x + off + bj * 128 + n * 16); *(f32x4*)(out + off + bj * 128 + n * 16) = xv + gv[bj][n] * acc[ai][bj][m][n]; } }
    }
};

constexpr int CW_QUEUE = 8192;
__device__ __forceinline__ void mix_phase(Frame& F, volatile LAS unsigned* MISC) {
    const float lam = F.par[PAR_SCAL], shift2 = F.par[PAR_SCAL + 1];
    const int x = (F.G == 256) ? (F.vcu >> 5) : 0, nq = (F.G == 256) ? 8 : 1;
    unsigned* ctr = (unsigned*)(F.ws + WS_CTL) + CW_QUEUE + 64 * x;
    const int n_h = 128 / nq, n_a = 2048 / nq, n_g = 256 / nq;
    for (;;) {
        if (F.tid == 0) MISC[16] = __hip_atomic_fetch_add(ctr, 1u, __ATOMIC_RELAXED, __HIP_MEMORY_SCOPE_AGENT);
        __syncthreads();
        const int item = __builtin_amdgcn_readfirstlane((int)MISC[16]);
        __syncthreads();
        if (item >= n_h + n_a + n_g) break;
        if (item < n_h) { const int u = item * nq + x;
#if defined(REP_HG)
            hg::hgrn_unit<REP_HG - 1>(u >> 4, (u >> 1) & 7, u & 1, F.ws, F.lds, (unsigned short*)(F.outb + OUT_YH));
#endif
            hg::hgrn_unit<0>(u >> 4, (u >> 1) & 7, u & 1, F.ws, F.lds, nullptr); }
        else if (item >= n_h + n_a) { const int gi = (item - n_h - n_a) * nq + x;
            SchedOne Sc{gi >> 1, 8 + 2 * (gi & 1), (const char*)(F.outb + OUT_H), (const char*)(F.ws + WS_WIN + (size_t)7168 * 1024 * 2)};
            EpiZ E{F.ws, F.in[IN_HG], F.lds, F.outb};
            pg8::gemm_phase<EpiZ, SchedOne, true, true>(F.lds, D, Sc, E); }
        else { const int a = item - n_h, bh = (a >> 5) * nq + x, qb = a & 31, b = bh >> 3, h = bh & 7;
            const size_t qoff = ((size_t)b * T + (size_t)qb * 128) * 1024 + h * 128;
            const bf16_t* Qb = (const bf16_t*)(F.ws + WS_Q) + qoff; bf16_t* Ob = (bf16_t*)(F.ws + WS_Q) + qoff;
            const bf16_t* Kh = (const bf16_t*)(F.ws + WS_KALL) + (size_t)bh * S * 128;
            const bf16_t* Vh = (const bf16_t*)(F.ws + WS_VALL) + (size_t)bh * S * 128;
#if defined(REP_ATT)
            attn::attn_unit<REP_ATT - 1>(Qb, (bf16_t*)(F.outb + OUT_YH) + qoff, Kh, Vh, lam, shift2, F.in[IN_SUBG], (char*)F.ldsg, F.lds);
#endif
            attn::attn_unit<0>(Qb, Ob, Kh, Vh, lam, shift2, F.in[IN_SUBG], (char*)F.ldsg, F.lds); }
    }
}

constexpr int N_PHASES = 9;
__global__ void __launch_bounds__(512, 2) mega_fwd(Args args) {
    extern __shared__ __attribute__((aligned(16))) unsigned char lds[];
    Frame F;
    F.lds = (LAS unsigned char*)lds; F.ldsg = lds;
    F.tid = threadIdx.x; F.lane = F.tid & 63; F.wave = __builtin_amdgcn_readfirstlane(F.tid >> 6);
    F.G = gridDim.x; { const int bx = blockIdx.x; F.vcu = (F.G % 8 == 0) ? (bx % 8) * (F.G / 8) + bx / 8 : bx; }
#pragma unroll
    for (int i = 0; i < 21; ++i) F.in[i] = args.in[i];
    F.ws = args.ws; F.outb = (unsigned char*)args.out; F.par = (float*)(args.ws + WS_PAR);
    volatile LAS unsigned* MISC = (volatile LAS unsigned*)(F.lds + MISC_OFF);
    for (int u = F.tid; u < (LDS_BYTES - LDSCTL_OFF) / 4; u += 512) ((LAS unsigned*)(F.lds + LDSCTL_OFF))[u] = 0u;
    __syncthreads();
    XcdBarrier bar; bar.bar = (unsigned*)(args.ws + WS_CTL) + CW_BAR; bar.x = 0; bar.st = nullptr;
    if (MK_ONE_LAUNCH) bar = xcd_barrier_post((unsigned*)(args.ws + WS_CTL) + CW_BAR, MISC + 8);
    const int lo = args.ph_lo, hi = args.ph_hi;
#ifndef REPEAT_MASK
#define REPEAT_MASK 0
#endif
#ifndef PH_MASK
#define PH_MASK 0x1ff
#endif
#define IN(k) (((PH_MASK >> (k)) & 1) && lo <= (k) && (k) < hi)
#define REP(k) (((REPEAT_MASK >> (k)) & 1) ? 2 : 1)
#define SEAM(k) do { if (IN(k) && IN((k) + 1)) xcd_barrier(bar); } while (0)
    if (IN(0)) for (int rep_ = 0; rep_ < REP(0); ++rep_) { p0a(F); __syncthreads(); } SEAM(0);
    if (IN(1)) for (int rep_ = 0; rep_ < REP(1); ++rep_) { p0b(F); p0_weights(F); __syncthreads(); } SEAM(1);
#if defined(REP_P1)
    if (IN(2)) { SchedIn Sc{F.G, (int)blockIdx.x, (const char*)(F.outb + OUT_H), (const char*)(F.ws + WS_HC), (const char*)(F.ws + WS_WIN)};
        EpiProbe<REP_P1> E{F.outb + OUT_YH};
        pg8::gemm_phase<EpiProbe<REP_P1>, SchedIn, true, true>(F.lds, D, Sc, E); }
#endif
    if (IN(2)) for (int rep_ = 0; rep_ < REP(2); ++rep_) {
        SchedIn Sc{F.G, (int)blockIdx.x, (const char*)(F.outb + OUT_H), (const char*)(F.ws + WS_HC), (const char*)(F.ws + WS_WIN)};
        EpiIn E{F.ws, F.par, F.in[IN_KG], F.in[IN_QG]};
        pg8::gemm_phase<EpiIn, SchedIn, true, true>(F.lds, D, Sc, E);
    } SEAM(2);
    if (IN(4)) { mix_phase(F, MISC); } SEAM(4);
    if (IN(6)) for (int rep_ = 0; rep_ < REP(6); ++rep_) {
        SchedZ Sc{F.G, (int)blockIdx.x, (const char*)(F.outb + OUT_H), (const char*)(F.ws + WS_WIN + (size_t)7168 * 1024 * 2)};
        EpiZ E{F.ws, F.in[IN_HG], F.lds, F.outb};
        pg8::gemm_phase<EpiZ, SchedZ, true, true>(F.lds, D, Sc, E);
    } SEAM(6);
    if (IN(7)) for (int rep_ = 0; rep_ < REP(7); ++rep_) {
        SchedM Sc{F.G, (int)blockIdx.x, (const char*)(F.ws + WS_YA), (const char*)(F.ws + WS_WBA)};
        EpiM E{F.ws, F.outb};
        pg8::gemm_phase<EpiM, SchedM, true, true>(F.lds, 2 * D, Sc, E);
    } SEAM(7);
    if (IN(8)) for (int rep_ = 0; rep_ < REP(8); ++rep_) {
        SchedO Sc{F.G, (int)blockIdx.x, (const char*)(F.ws + WS_MM), (const char*)(F.ws + WS_WO)};
        EpiOut E{F.in[IN_X], args.out, F.par};
        pg8::gemm_phase<EpiOut, SchedO, true, true>(F.lds, D, Sc, E);
    }
#undef IN
#undef SEAM
}

extern "C" void kernel_launch(void* const* d_in, const int* in_sizes, int n_in, void* d_out, int out_size, void* d_ws, size_t ws_size, hipStream_t stream) {
    static int grid = 0;
    if (grid == 0) {
        if (n_in != 21 || in_sizes[0] != M * D || out_size != M * D || ws_size < WS_END) { fprintf(stderr, "kernel_launch: unexpected shapes: n_in %d in0 %d out %d ws %zu (need %zu)\n", n_in, n_in > 0 ? in_sizes[0] : -1, out_size, ws_size, (size_t)WS_END); grid = -1; return; }
        int dev = 0, cus = 0, per_cu = 0;
        if (hipGetDevice(&dev) != hipSuccess || hipDeviceGetAttribute(&cus, hipDeviceAttributeMultiprocessorCount, dev) != hipSuccess) { grid = -1; return; }
        if (hipFuncSetAttribute((const void*)mega_fwd, hipFuncAttributeMaxDynamicSharedMemorySize, LDS_BYTES) != hipSuccess) { fprintf(stderr, "kernel_launch: hipFuncSetAttribute failed\n"); grid = -1; return; }
        if (hipOccupancyMaxActiveBlocksPerMultiprocessor(&per_cu, (const void*)mega_fwd, 512, LDS_BYTES) != hipSuccess || per_cu < 1) fprintf(stderr, "kernel_launch: occupancy query reports %d\n", per_cu);
        (void)hipGetLastError();
        grid = cus;
        if (grid != 256) fprintf(stderr, "kernel_launch: %d CUs; this build assumes 256\n", grid);
    }
    if (grid < 0) return;
    (void)hipMemsetAsync((char*)d_ws + WS_CTL, 0, CTL_ZERO_BYTES, stream);
    Args a{};
    for (int i = 0; i < 21; ++i) a.in[i] = (const float*)d_in[i];
    a.out = (float*)d_out; a.ws = (unsigned char*)d_ws;
    if (MK_ONE_LAUNCH) { a.ph_lo = 0; a.ph_hi = N_PHASES; hipLaunchKernelGGL(mega_fwd, dim3(grid), dim3(512), LDS_BYTES, stream, a); }
    else for (int p = 0; p < N_PHASES; ++p) { a.ph_lo = p; a.ph_hi = p + 1; hipLaunchKernelGGL(mega_fwd, dim3(grid), dim3(512), LDS_BYTES, stream, a); }
    const hipError_t le = hipPeekAtLastError();
    if (le != hipSuccess) fprintf(stderr, "kernel_launch: launch failed: %s\n", hipGetErrorName(le));
}
```

```cpp
#include <hip/hip_runtime.h>
#include <cstdio>
#include <cstdint>

#ifndef MK_ONE_LAUNCH
#define MK_ONE_LAUNCH 1
#endif

constexpr int NB = 8, T = 4096, D = 1024, LC = 256, S = LC + T, M = NB * T, MC = NB * LC, MALL = NB * S;
constexpr int NH = 8;
constexpr int NIN = 11264;
constexpr float EPS = 1e-6f;
constexpr float LAM_INIT = 0.2f;
constexpr float LOG2E = 1.4426950408889634f;

#define GAS __attribute__((address_space(1)))
#define LAS __attribute__((address_space(3)))
typedef unsigned short bf16_t;
typedef short bf16x8 __attribute__((ext_vector_type(8)));
typedef short s16x4 __attribute__((ext_vector_type(4)));
typedef float f32x4 __attribute__((ext_vector_type(4)));
typedef float f32x2 __attribute__((ext_vector_type(2)));
typedef float f32x16 __attribute__((ext_vector_type(16)));
typedef unsigned u32x4 __attribute__((ext_vector_type(4)));
typedef unsigned u32x2 __attribute__((ext_vector_type(2)));
typedef GAS unsigned gu32;

constexpr size_t MiB = 1u << 20;
constexpr size_t WS_CTL = 0, CTL_ZERO_BYTES = 1 * MiB;
constexpr size_t WS_PAR = 1 * MiB;
constexpr size_t WS_WIN = 2 * MiB;
constexpr size_t WS_WBA = 24 * MiB, WS_WBH = 26 * MiB, WS_WO = 28 * MiB;
constexpr size_t WS_HC = 30 * MiB;
constexpr size_t WS_KALL = 34 * MiB, WS_VALL = 102 * MiB, WS_IALL = 170 * MiB, WS_GF = 238 * MiB, WS_GB = 306 * MiB;
constexpr size_t WS_Q = 374 * MiB, WS_QH = 438 * MiB;
constexpr size_t WS_END = 502 * MiB;
constexpr size_t WS_YA = 34 * MiB, WS_YHH = 98 * MiB, WS_GA = 162 * MiB, WS_GH = 438 * MiB, WS_MM = 290 * MiB;
constexpr size_t OUT_H = 0, OUT_YH = 64 * MiB, OUT_GA = 64 * MiB;
constexpr int PAR_MOD = 0;
constexpr int PAR_LBF = 9 * 3072, PAR_LBB = PAR_LBF + 1024;
constexpr int PAR_ROPE = PAR_LBB + 1024;
constexpr int PAR_SCAL = PAR_ROPE + 2048;
constexpr int CW_BAR = 4096;

constexpr int RING_BYTES = 131072;
constexpr int LDSCTL_OFF = RING_BYTES, MISC_OFF = LDSCTL_OFF + 320;
constexpr int LDS_BYTES = 147456;
constexpr int XS_OFF = 136 * 1024;

#define LDS_WAIT() asm volatile("s_waitcnt lgkmcnt(0)" ::: "memory")
#define VM_WAIT() asm volatile("s_waitcnt vmcnt(0)" ::: "memory")
__device__ __forceinline__ unsigned f2bf(float f) { unsigned u = __builtin_bit_cast(unsigned, f); return (u + 0x7fffu + ((u >> 16) & 1u)) >> 16; }
__device__ __forceinline__ unsigned pk2(float lo, float hi) { return f2bf(lo) | (f2bf(hi) << 16); }
__device__ __forceinline__ float bf2f(unsigned short b) { return __builtin_bit_cast(float, (unsigned)b << 16); }
__device__ __forceinline__ float bflo(unsigned w) { return __builtin_bit_cast(float, w << 16); }
__device__ __forceinline__ float bfhi(unsigned w) { return __builtin_bit_cast(float, w & 0xffff0000u); }
__device__ __forceinline__ unsigned cvt_pk_bf16(float lo, float hi) { unsigned r; asm volatile("v_cvt_pk_bf16_f32 %0, %1, %2" : "=v"(r) : "v"(lo), "v"(hi)); return r; }
__device__ __forceinline__ unsigned pk_f16(float lo, float hi) { _Float16 a = (_Float16)lo, b = (_Float16)hi; return (unsigned)__builtin_bit_cast(unsigned short, a) | ((unsigned)__builtin_bit_cast(unsigned short, b) << 16); }
__device__ __forceinline__ float f16lo(unsigned w) { return (float)__builtin_bit_cast(_Float16, (unsigned short)(w & 0xffffu)); }
__device__ __forceinline__ float f16hi(unsigned w) { return (float)__builtin_bit_cast(_Float16, (unsigned short)(w >> 16)); }
__device__ __forceinline__ float sigmoidf_(float v) { return __builtin_amdgcn_rcpf(1.f + __builtin_amdgcn_exp2f(-v * LOG2E)); }
__device__ __forceinline__ float siluf_(float v) { return v * sigmoidf_(v); }
__device__ __forceinline__ float wave_sum(float v) {
#pragma unroll
    for (int o = 1; o < 64; o <<= 1) v += __shfl_xor(v, o);
    return v;
}

namespace pg8 {
constexpr int BM = 256, BK = 64, HALF = 128, HTB = HALF * BK * 2, STAGE_BYTES = 8 * HTB, NXCD = 8, WGM = 2;
__host__ __device__ __forceinline__ int lds_byte(int r, int c) { const int st = (r >> 4) * 2 + (c >> 5), rr = r & 15, cc = c & 31, ob = rr * 64 + cc * 2; return st * 1024 + (ob ^ (((ob >> 9) & 1) << 5)); }
__host__ __device__ __forceinline__ void stage_rc(int b, int& R, int& C) { const int st = b / 1024, sb = b % 1024, swz = sb ^ (((sb >> 9) & 1) << 5); R = (st >> 1) * 16 + swz / 64; C = (st & 1) * 32 + (swz % 64) / 2; }
__host__ __device__ __forceinline__ int perm32(int rho) { const int n = rho >> 4, i = rho & 15; return 8 * (i >> 2) + 4 * n + (i & 3); }

struct Unit { int pm, pn, kind; const char* A; const char* B; };

__device__ __forceinline__ void tile_map(int wgid_in, int nM, int nN, int& pm, int& pn) {
    const int nwg = nM * nN; int wgid = wgid_in;
    { const int q = nwg / NXCD, r = nwg % NXCD, xcd = wgid % NXCD, off = wgid / NXCD; wgid = (xcd < r ? xcd * (q + 1) : r * (q + 1) + (xcd - r) * q) + off; }
    const int nig = WGM * nN, gid = wgid / nig, fm = gid * WGM, gsz = (nM - fm) < WGM ? (nM - fm) : WGM;
    pm = fm + ((wgid % nig) % gsz); pn = (wgid % nig) / gsz;
}

template <class Epi, class Sched, bool ALIGN_EPI, bool SP2>
__device__ __forceinline__ void gemm_phase(LAS unsigned char* lds, const int K, const Sched& S, const Epi& E) {
    int tid_ = threadIdx.x; asm volatile("" : "+v"(tid_));
    const int tid = tid_, wid = __builtin_amdgcn_readfirstlane(tid >> 6), lane = tid & 63, wr = wid >> 2, wc = wid & 3, fr = lane & 15, fq = lane >> 4;
    const int nt = K / BK;
    unsigned voffA[2], voffB[2];
#pragma unroll
    for (int i = 0; i < 2; ++i) { int R, C; stage_rc(tid * 16 + i * 8192, R, C); const int Rb = Epi::PERM ? ((R & ~31) + perm32(R & 31)) : R;
        voffA[i] = (unsigned)(R * K + C) * 2u; voffB[i] = (unsigned)(Rb * K + C) * 2u; }
    const size_t kstep = (size_t)(BK * 2);
    const size_t hstep = (size_t)HALF * K * 2;
    const unsigned ldsw = (unsigned)wid * 1024u;
    const int aoff = lds_byte(wr * 64 + fr, fq * 8), boff = lds_byte(wc * 32 + fr, fq * 8);
#define PG8_SA(b, h) (((b) * 2 + (h)) * HTB)
#define PG8_SB(b, h) ((4 + (b) * 2 + (h)) * HTB)
#define PG8_STAGE(bufoff, gbase, voff) do { _Pragma("unroll") for (int _i = 0; _i < 2; ++_i) \
        __builtin_amdgcn_global_load_lds((const unsigned*)((const char*)(gbase) + (voff)[_i]), (LAS unsigned*)(lds + (bufoff) + ldsw + _i * 8192), 16, 0, 0); } while (0)
#define PG8_LDA(dst, b, h) do { _Pragma("unroll") for (int m = 0; m < 4; ++m) _Pragma("unroll") for (int k = 0; k < 2; ++k) dst[m][k] = *(const LAS bf16x8*)(lds + PG8_SA(b, h) + aoff + m * 2048 + k * 1024); } while (0)
#define PG8_LDB(dst, b, h) do { _Pragma("unroll") for (int n = 0; n < 2; ++n) _Pragma("unroll") for (int k = 0; k < 2; ++k) dst[n][k] = *(const LAS bf16x8*)(lds + PG8_SB(b, h) + boff + n * 2048 + k * 1024); } while (0)
#define PG8_MMA(ai, bj, At, Bt) do { __builtin_amdgcn_s_setprio(1); _Pragma("unroll") for (int m = 0; m < 4; ++m) _Pragma("unroll") for (int n = 0; n < 2; ++n) _Pragma("unroll") for (int k = 0; k < 2; ++k) \
        acc[ai][bj][m][n] = __builtin_amdgcn_mfma_f32_16x16x32_bf16(Bt[n][k], At[m][k], acc[ai][bj][m][n], 0, 0, 0); __builtin_amdgcn_s_setprio(0); } while (0)
#define PG8_WAIT_V(n) asm volatile("s_waitcnt vmcnt(" #n ")" ::: "memory")
#define PG8_WAIT_L(n) asm volatile("s_waitcnt lgkmcnt(" #n ")" ::: "memory")
#define PG8_BAR __builtin_amdgcn_s_barrier()
#define PG8_SCHED __builtin_amdgcn_sched_barrier(0)
    Unit cur, nxt; int ui = 0;
    if (!S.next(0, cur)) return;
    f32x4 acc[2][2][4][2];
#pragma unroll
    for (int a = 0; a < 2; ++a)
#pragma unroll
        for (int b = 0; b < 2; ++b)
#pragma unroll
            for (int m = 0; m < 4; ++m)
#pragma unroll
                for (int n = 0; n < 2; ++n) acc[a][b][m][n] = (f32x4){0.f, 0.f, 0.f, 0.f};
    bf16x8 At[4][2], B0[2][2], B1[2][2];
    const char* cA = cur.A; const char* cB = cur.B;
    if constexpr (SP2) {
        PG8_STAGE(PG8_SB(0, 0), cB, voffB); PG8_STAGE(PG8_SB(0, 1), cB + hstep, voffB); PG8_STAGE(PG8_SA(0, 0), cA, voffA); PG8_STAGE(PG8_SA(0, 1), cA + hstep, voffA);
        if (wr == 1) PG8_BAR;
        PG8_WAIT_V(2); PG8_BAR;
        PG8_STAGE(PG8_SB(1, 0), cB + kstep, voffB); PG8_STAGE(PG8_SA(1, 0), cA + kstep, voffA); PG8_STAGE(PG8_SB(1, 1), cB + hstep + kstep, voffB);
        PG8_WAIT_V(6); PG8_BAR;
    } else {
        PG8_STAGE(PG8_SB(0, 0), cB, voffB); PG8_STAGE(PG8_SA(0, 0), cA, voffA); PG8_STAGE(PG8_SB(0, 1), cB + hstep, voffB); PG8_STAGE(PG8_SA(0, 1), cA + hstep, voffA);
        if (wr == 1) PG8_BAR;
        PG8_WAIT_V(4); PG8_BAR;
        PG8_STAGE(PG8_SB(1, 0), cB + kstep, voffB); PG8_STAGE(PG8_SA(1, 0), cA + kstep, voffA); PG8_STAGE(PG8_SB(1, 1), cB + hstep + kstep, voffB);
        PG8_WAIT_V(6); PG8_BAR;
    }
    for (;;) {
        const bool has_next = S.next(ui + 1, nxt);
        const char* nA = has_next ? nxt.A : cA; const char* nB = has_next ? nxt.B : cB;
        for (int t = 0; t < nt; t += 2) {
            if constexpr (Epi::MID) { if (t == nt / 2) E.mid(acc, cur, wr, wc, fr, fq); }
            const bool last = (t == nt - 2);
            const char* a1 = cA + (size_t)(t + 1) * kstep;
            const char* a2 = last ? nA : cA + (size_t)(t + 2) * kstep; const char* b2 = last ? nB : cB + (size_t)(t + 2) * kstep;
            const char* a3 = a2 + kstep; const char* b3 = b2 + kstep;
            if constexpr (SP2) {
            PG8_LDB(B0, 0, 0); PG8_LDB(B1, 0, 1); PG8_SCHED; PG8_LDA(At, 0, 0); PG8_STAGE(PG8_SA(1, 1), a1 + hstep, voffA);
            PG8_WAIT_V(8); PG8_WAIT_L(0); PG8_BAR; PG8_MMA(0, 0, At, B0); PG8_MMA(0, 1, At, B1); PG8_BAR; PG8_SCHED;
            PG8_LDA(At, 0, 1); PG8_STAGE(PG8_SB(0, 0), b2, voffB); PG8_STAGE(PG8_SB(0, 1), b2 + hstep, voffB); PG8_STAGE(PG8_SA(0, 0), a2, voffA);
            PG8_WAIT_V(8); PG8_WAIT_L(0); PG8_BAR; PG8_MMA(1, 0, At, B0); PG8_MMA(1, 1, At, B1); PG8_BAR; PG8_SCHED;
            PG8_LDB(B0, 1, 0); PG8_LDB(B1, 1, 1); PG8_SCHED; PG8_LDA(At, 1, 0); PG8_STAGE(PG8_SA(0, 1), a2 + hstep, voffA);
            PG8_WAIT_V(8); PG8_WAIT_L(0); PG8_BAR; PG8_MMA(0, 0, At, B0); PG8_MMA(0, 1, At, B1); PG8_BAR; PG8_SCHED;
            PG8_LDA(At, 1, 1); PG8_STAGE(PG8_SB(1, 0), b3, voffB); PG8_STAGE(PG8_SB(1, 1), b3 + hstep, voffB); PG8_STAGE(PG8_SA(1, 0), a3, voffA);
            PG8_WAIT_V(8); PG8_WAIT_L(0); PG8_BAR; PG8_MMA(1, 0, At, B0); PG8_MMA(1, 1, At, B1); PG8_BAR; PG8_SCHED;
            } else {
            PG8_LDB(B0, 0, 0); PG8_SCHED; PG8_LDA(At, 0, 0); PG8_STAGE(PG8_SA(1, 1), a1 + hstep, voffA);
            PG8_WAIT_L(8); PG8_BAR; PG8_WAIT_L(0); PG8_MMA(0, 0, At, B0); PG8_BAR; PG8_SCHED;
            PG8_LDB(B1, 0, 1); PG8_STAGE(PG8_SB(0, 0), b2, voffB);
            PG8_BAR; PG8_WAIT_L(0); PG8_MMA(0, 1, At, B1); PG8_BAR;
            PG8_LDA(At, 0, 1); PG8_STAGE(PG8_SA(0, 0), a2, voffA);
            PG8_BAR; PG8_WAIT_L(0); PG8_MMA(1, 0, At, B0); PG8_BAR; PG8_SCHED;
            PG8_STAGE(PG8_SB(0, 1), b2 + hstep, voffB);
            PG8_WAIT_V(6); PG8_BAR; PG8_MMA(1, 1, At, B1); PG8_BAR;
            PG8_LDB(B0, 1, 0); PG8_SCHED; PG8_LDA(At, 1, 0); PG8_STAGE(PG8_SA(0, 1), a2 + hstep, voffA);
            PG8_WAIT_L(8); PG8_BAR; PG8_WAIT_L(0); PG8_MMA(0, 0, At, B0); PG8_BAR; PG8_SCHED;
            PG8_LDB(B1, 1, 1); PG8_STAGE(PG8_SB(1, 0), b3, voffB);
            PG8_BAR; PG8_WAIT_L(0); PG8_MMA(0, 1, At, B1); PG8_BAR;
            PG8_LDA(At, 1, 1); PG8_STAGE(PG8_SA(1, 0), a3, voffA);
            PG8_BAR; PG8_WAIT_L(0); PG8_MMA(1, 0, At, B0); PG8_BAR; PG8_SCHED;
            PG8_STAGE(PG8_SB(1, 1), b3 + hstep, voffB);
            PG8_WAIT_V(6); PG8_BAR; PG8_MMA(1, 1, At, B1); PG8_BAR;
            }
        }
        if constexpr (ALIGN_EPI) { if (wr == 0) PG8_BAR; }
        E(acc, cur, wr, wc, fr, fq);
        if (!has_next) break;
#pragma unroll
        for (int a = 0; a < 2; ++a)
#pragma unroll
            for (int b = 0; b < 2; ++b)
#pragma unroll
                for (int m = 0; m < 4; ++m)
#pragma unroll
                    for (int n = 0; n < 2; ++n) acc[a][b][m][n] = (f32x4){0.f, 0.f, 0.f, 0.f};
        cur = nxt; cA = nA; cB = nB; ++ui;
        if constexpr (ALIGN_EPI) { if (wr == 1) PG8_BAR; }
    }
    PG8_WAIT_V(0);
    if constexpr (!ALIGN_EPI) { if (wr == 0) PG8_BAR; }
    PG8_BAR;
#undef PG8_SA
#undef PG8_SB
#undef PG8_STAGE
#undef PG8_LDA
#undef PG8_LDB
#undef PG8_MMA
#undef PG8_WAIT_V
#undef PG8_WAIT_L
#undef PG8_BAR
#undef PG8_SCHED
}
}

#define XB_TMO      128
#define XB_XCNT(j)  (256  + 64 * (j))
#define XB_XSUB(j)  (1280 + 64 * (j))
#define XB_XGEN(j)  (2304 + 64 * (j))
#define XB_TOP      3328
#define XB_TOPGEN   3392
#define XCD_BAR_WORDS 3456
#define XB_SPIN_CAP (1u << 20)
__device__ __forceinline__ unsigned xb_ld(unsigned* p)              { return __hip_atomic_load(p, __ATOMIC_RELAXED, __HIP_MEMORY_SCOPE_AGENT); }
__device__ __forceinline__ unsigned xb_add(unsigned* p, unsigned v) { return __hip_atomic_fetch_add(p, v, __ATOMIC_RELAXED, __HIP_MEMORY_SCOPE_AGENT); }
__device__ __forceinline__ unsigned xb_xcc_id() { return (unsigned)__builtin_amdgcn_s_getreg((3 << 11) | 20) & 0xFu; }
#define XB_SPIN(cond, bar) do { unsigned _sp = 0; while (cond) { __builtin_amdgcn_s_sleep(1); \
    if ((++_sp & 255u) == 0u) { if (xb_ld(&(bar)[XB_TMO])) break; if (_sp > XB_SPIN_CAP) { atomicAdd(&(bar)[XB_TMO], 1u); break; } } } } while (0)
struct XcdBarrier { unsigned* bar; unsigned x; volatile LAS unsigned* st; };
__device__ __forceinline__ XcdBarrier xcd_barrier_post(unsigned* bar, volatile LAS unsigned* st) {
    XcdBarrier b; b.bar = bar; b.x = xb_xcc_id(); b.st = st;
    if (threadIdx.x == 0) (void)xb_add(&bar[XB_XCNT(b.x)], 1u);
    return b;
}
__device__ __forceinline__ void xcd_barrier_complete(unsigned* bar, unsigned x, unsigned& nloc, unsigned& nx) {
    const unsigned G = gridDim.x * gridDim.y * gridDim.z;
    unsigned sum, cnt, mine, sp = 0u;
    for (;;) {
        sum = 0u; cnt = 0u; mine = 0u;
#pragma unroll
        for (unsigned j = 0; j < 16; ++j) { const unsigned c = xb_ld(&bar[XB_XCNT(j)]); sum += c; cnt += (c > 0u) ? 1u : 0u; mine = (j == x) ? c : mine; }
        if (sum == G) break;
        __builtin_amdgcn_s_sleep(1);
        if ((++sp & 255u) == 0u) { if (xb_ld(&bar[XB_TMO])) break; if (sp > XB_SPIN_CAP) { atomicAdd(&bar[XB_TMO], 1u); break; } }
    }
    nloc = mine > 0u ? mine : 1u; nx = cnt > 0u ? cnt : 1u;
}
__device__ __forceinline__ void xcd_barrier(const XcdBarrier& b) {
    asm volatile("s_waitcnt vmcnt(0)" ::: "memory");
    __syncthreads();
    if (threadIdx.x == 0) {
        unsigned* bar = b.bar;
        __builtin_amdgcn_s_waitcnt(0);
        unsigned nloc = b.st[0], nx = b.st[1];
        if (nloc == 0u) { xcd_barrier_complete(bar, b.x, nloc, nx); b.st[0] = nloc; b.st[1] = nx; }
        const unsigned old = xb_add(&bar[XB_XSUB(b.x)], 1u);
        const unsigned gen = old / nloc;
        if (old + 1u == (gen + 1u) * nloc) {
            __builtin_amdgcn_fence(__ATOMIC_RELEASE, "agent");
            asm volatile("s_waitcnt vmcnt(0)" ::: "memory");
            const unsigned og = xb_add(&bar[XB_TOP], 1u);
            const unsigned tg = og / nx;
            if (og + 1u == (tg + 1u) * nx) xb_add(&bar[XB_TOPGEN], 1u);
            else XB_SPIN(xb_ld(&bar[XB_TOPGEN]) == tg, bar);
            __builtin_amdgcn_fence(__ATOMIC_ACQUIRE, "agent");
            xb_add(&bar[XB_XGEN(b.x)], 1u);
            asm volatile("s_waitcnt vmcnt(0)" ::: "memory");
        } else {
            XB_SPIN(xb_ld(&bar[XB_XGEN(b.x)]) == gen, bar);
            __builtin_amdgcn_fence(__ATOMIC_ACQUIRE, "agent");
            asm volatile("s_waitcnt vmcnt(0)" ::: "memory");
        }
    }
    __syncthreads();
}

struct Args { const float* in[21]; float* out; unsigned char* ws; int ph_lo, ph_hi; };
struct Frame {
    LAS unsigned char* lds; unsigned char* ldsg;
    int tid, lane, wave, vcu, G;
    const float* in[21]; unsigned char* ws; unsigned char* outb; float* par;
};
enum { IN_X = 0, IN_C, IN_CTX, IN_CCTX, IN_WMOD, IN_BMOD, IN_NG, IN_WIN, IN_QG, IN_KG, IN_LQ1, IN_LK1, IN_LQ2, IN_LK2, IN_SUBG, IN_LBF, IN_LBB, IN_HG, IN_WBA, IN_WBH, IN_WO };

__device__ __forceinline__ int qk_slot(int l) { return 128 * ((l >> 5) & 1) + 32 * (l >> 6) + 8 * ((l >> 2) & 3) + 4 * ((l >> 4) & 1) + (l & 3); }
template <bool QKPERM>
__device__ __forceinline__ void p0_transpose_item(const float* W, int K, int N, bf16_t* WT, LAS float* scr, int item, int lane, const int opitch) {
    const int nblk = N / 32, kb = item / nblk, nb = item % nblk, k0 = 64 * kb, n0 = 32 * nb;
    float wv[32];
#pragma unroll
    for (int i = 0; i < 32; ++i) wv[i] = W[(size_t)(k0 + 2 * i + (lane >> 5)) * N + n0 + (lane & 31)];
#pragma unroll
    for (int i = 0; i < 32; ++i) scr[(2 * i + (lane >> 5)) * 33 + (lane & 31)] = wv[i];
    LDS_WAIT(); asm volatile("" ::: "memory");
    const int c = lane & 7;
#pragma unroll
    for (int j = 0; j < 4; ++j) { const int n = (lane >> 3) + 8 * j; const LAS float* s = scr + (8 * c) * 33 + n;
        u32x4 o; o.x = pk2(s[0 * 33], s[1 * 33]); o.y = pk2(s[2 * 33], s[3 * 33]); o.z = pk2(s[4 * 33], s[5 * 33]); o.w = pk2(s[6 * 33], s[7 * 33]);
        int nd = n0 + n; if constexpr (QKPERM) { if (nd < 1024 || (nd >= 5120 && nd < 6144)) nd = (nd & ~255) + qk_slot(nd & 255); }
        *(GAS u32x4*)(WT + (size_t)nd * opitch + k0 + 8 * c) = o; }
    LDS_WAIT(); asm volatile("" ::: "memory");
}
__device__ __forceinline__ void p0_weights(Frame& F) {
    {
        LAS float* scr = (LAS float*)(F.lds + F.wave * 16384);
        const int gw = F.vcu * 8 + F.wave, NGW = F.G * 8;
        constexpr int I_IN = (D / 64) * (NIN / 32), I_SQ = (D / 64) * (D / 32);
        constexpr int NITEMS = I_IN + 3 * I_SQ;
        for (int it = gw; it < NITEMS; it += NGW) {
            int r = it;
            if (r < I_IN) { p0_transpose_item<true>(F.in[IN_WIN], D, NIN, (bf16_t*)(F.ws + WS_WIN), scr, r, F.lane, D); continue; } r -= I_IN;
            if (r < I_SQ) { p0_transpose_item<false>(F.in[IN_WBA], D, D, (bf16_t*)(F.ws + WS_WBA), scr, r, F.lane, 2 * D); continue; } r -= I_SQ;
            if (r < I_SQ) { p0_transpose_item<false>(F.in[IN_WBH], D, D, (bf16_t*)(F.ws + WS_WBA) + D, scr, r, F.lane, 2 * D); continue; } r -= I_SQ;
            p0_transpose_item<false>(F.in[IN_WO], D, D, (bf16_t*)(F.ws + WS_WO), scr, r, F.lane, D);
        }
    }
}
__device__ __forceinline__ void p0a(Frame& F) {
    const int j = (int)blockIdx.x;
    if (j < 96) {
        LAS float* sc = (LAS float*)F.lds;
        LAS float* red = (LAS float*)(F.lds + 40960);
        { float cv[18];
#pragma unroll
          for (int q = 0; q < 18; ++q) { const int i = F.tid + 512 * q, k = i & 1023; cv[q] = (q < 16) ? F.in[IN_C][(q >> 1) * 1024 + k] : F.in[IN_CCTX][k]; }
#pragma unroll
          for (int q = 0; q < 18; ++q) sc[F.tid + 512 * q] = cv[q] / (1.f + __expf(-cv[q])); }
        __syncthreads();
        const int col = F.tid & 31, ks = F.tid >> 5, n = 32 * j + col;
        float acc[9];
#pragma unroll
        for (int r = 0; r < 9; ++r) acc[r] = 0.f;
        const float* wm = F.in[IN_WMOD];
        for (int kb = 0; kb < 64; kb += 16) {
            float w[16];
#pragma unroll
            for (int u = 0; u < 16; ++u) w[u] = wm[(size_t)(ks * 64 + kb + u) * 3072 + n];
#pragma unroll
            for (int u = 0; u < 16; ++u) { const int k = ks * 64 + kb + u;
#pragma unroll
                for (int r = 0; r < 9; ++r) acc[r] += sc[r * 1024 + k] * w[u]; } }
#pragma unroll
        for (int r = 0; r < 9; ++r) red[(ks * 9 + r) * 32 + col] = acc[r];
        __syncthreads();
        if (F.tid < 288) { const int r = F.tid >> 5, c2 = F.tid & 31; float s = 0.f;
#pragma unroll
            for (int q = 0; q < 16; ++q) s += red[(q * 9 + r) * 32 + c2];
            F.par[PAR_MOD + r * 3072 + 32 * j + c2] = s + F.in[IN_BMOD][32 * j + c2]; }
        __syncthreads();
    } else if (j == 96) {
        for (int i = F.tid; i < 1024; i += 512) {
            { const float p0 = F.in[IN_LBF][i], p1 = F.in[IN_LBF][1024 + i]; F.par[PAR_LBF + i] = 1.f / (1.f + expf(p1 - p0)); }
            { const float p0 = F.in[IN_LBB][i], p1 = F.in[IN_LBB][1024 + i]; F.par[PAR_LBB + i] = 1.f / (1.f + expf(p1 - p0)); }
            { const int pos = i >> 4, fi = i & 15; const double inv = exp(-(double)(2 * fi) / 32.0 * log(10000.0)); const double ang = (double)pos * inv;
              F.par[PAR_ROPE + 2 * i] = (float)cos(ang); F.par[PAR_ROPE + 2 * i + 1] = (float)sin(ang); }
        }
        if (F.tid < 64) {
            const int l = F.tid;
            const float d1 = wave_sum(F.in[IN_LQ1][l] * F.in[IN_LK1][l]), d2 = wave_sum(F.in[IN_LQ2][l] * F.in[IN_LK2][l]);
            float mq = fabsf(F.in[IN_QG][l]), mk = fabsf(F.in[IN_KG][l]);
#pragma unroll
            for (int o = 1; o < 64; o <<= 1) { mq = fmaxf(mq, __shfl_xor(mq, o)); mk = fmaxf(mk, __shfl_xor(mk, o)); }
            if (l == 0) { F.par[PAR_SCAL] = expf(d1) - expf(d2) + LAM_INIT; F.par[PAR_SCAL + 1] = 8.f * mq * mk * LOG2E * 1.01f; }
        }
    }
}
__device__ __forceinline__ void p0b(Frame& F) {
    const int gw = F.vcu * 8 + F.wave, NGW = F.G * 8;
    const GAS f32x4* gn = (const GAS f32x4*)F.in[IN_NG] + F.lane;
    for (int m0 = gw; m0 < M + MC; m0 += 2 * NGW) {
        f32x4 v[2][4]; float rstd[2]; const int mm[2] = {m0, m0 + NGW};
#pragma unroll
        for (int q = 0; q < 2; ++q) { const int m = mm[q] < M + MC ? mm[q] : m0; const float* xrow = (m < M) ? F.in[IN_X] + (size_t)m * D : F.in[IN_CTX] + (size_t)(m - M) * D;
            const GAS f32x4* xr = (const GAS f32x4*)xrow + F.lane;
#pragma unroll
            for (int j = 0; j < 4; ++j) v[q][j] = xr[64 * j]; }
#pragma unroll
        for (int q = 0; q < 2; ++q) { float s = 0.f;
#pragma unroll
            for (int j = 0; j < 4; ++j) s += (v[q][j].x * v[q][j].x + v[q][j].y * v[q][j].y) + (v[q][j].z * v[q][j].z + v[q][j].w * v[q][j].w);
            rstd[q] = 1.f / sqrtf(wave_sum(s) * (1.f / D) + EPS); }
#pragma unroll
        for (int q = 0; q < 2; ++q) { const int m = mm[q]; if (m >= M + MC) break;
            const bool lat = m < M; const int mr = lat ? (m >> 12) : 8;
            bf16_t* orow = lat ? (bf16_t*)(F.outb + OUT_H) + (size_t)m * D : (bf16_t*)(F.ws + WS_HC) + (size_t)(m - M) * D;
            const GAS f32x4* sh = (const GAS f32x4*)(F.par + PAR_MOD + mr * 3072) + F.lane;
            const GAS f32x4* scl = (const GAS f32x4*)(F.par + PAR_MOD + mr * 3072 + 1024) + F.lane;
            GAS u32x2* o8 = (GAS u32x2*)orow + F.lane;
#pragma unroll
            for (int j = 0; j < 4; ++j) { const f32x4 g = gn[64 * j], a = scl[64 * j], b = sh[64 * j];
                const f32x4 h = v[q][j] * rstd[q] * g * (a + 1.f) + b;
                u32x2 w; w.x = pk2(h.x, h.y); w.y = pk2(h.z, h.w); o8[64 * j] = w; } }
    }
}

struct SchedIn {
    int G, c; const char* H; const char* HC; const char* W;
    __device__ __forceinline__ bool next(int i, pg8::Unit& u) const {
        const int L = i * G + c; constexpr int NLAT = 128 * 28, NCTX = 8 * 20;
        if (L >= NLAT + NCTX) return false;
        if (L < NLAT) { pg8::tile_map(L, 128, 28, u.pm, u.pn); u.kind = 0; u.A = H + (size_t)u.pm * (256 * 1024 * 2); }
        else { const int r = L - NLAT; u.pm = r & 7; u.pn = r >> 3; u.kind = 1; u.A = HC + (size_t)u.pm * (256 * 1024 * 2); }
        u.B = W + (size_t)u.pn * (256 * 1024 * 2); return true;
    }
};
template <int MODE> struct EpiProbe {
    static constexpr bool PERM = true, MID = false;
    unsigned char* scratch;
    __device__ __forceinline__ void operator()(const f32x4 (&acc)[2][2][4][2], const pg8::Unit& u, int wr, int wc, int fr, int fq) const {
        if constexpr (MODE == 3) {
#pragma unroll
            for (int ai = 0; ai < 2; ++ai)
#pragma unroll
                for (int bj = 0; bj < 2; ++bj)
#pragma unroll
                    for (int m = 0; m < 4; ++m) asm volatile("" :: "v"(acc[ai][bj][m][0]), "v"(acc[ai][bj][m][1]));
            return; }
        bf16_t* base = (bf16_t*)scratch; const int row0 = (u.pm & 127) * 256 + wr * 64 + fr, cg0 = (u.pn & 3) * 256 + wc * 32 + 8 * fq;
#pragma unroll
        for (int ai = 0; ai < 2; ++ai)
#pragma unroll
            for (int m = 0; m < 4; ++m) { bf16_t* rowp = base + (size_t)(row0 + ai * 128 + m * 16) * 1024 + cg0;
#pragma unroll
                for (int bj = 0; bj < 2; ++bj) { const f32x4 v0 = acc[ai][bj][m][0], v1 = acc[ai][bj][m][1]; u32x4 w;
                    w.x = cvt_pk_bf16(v0[0], v0[1]); w.y = cvt_pk_bf16(v0[2], v0[3]); w.z = cvt_pk_bf16(v1[0], v1[1]); w.w = cvt_pk_bf16(v1[2], v1[3]);
                    *(u32x4*)(rowp + bj * 128) = w; } }
    }
};
struct EpiIn {
    static constexpr bool PERM = true, MID = false;
    unsigned char* ws; const float* par; const float* kgain; const float* qgain;
    __device__ __forceinline__ void qk_epi(const f32x4 (&acc)[2][2][4][2], const pg8::Unit& u, int wr, int wc, int fr, int fq, const bool isq) const {
        const int head = (u.pn & 3) * 2 + (wc >> 1), map = wc & 1;
        const float gs = isq ? 0.125f * LOG2E : 1.f; const float* gp = (isq ? qgain : kgain) + 4 * fq;
        const bool rope = (u.kind == 0);
        unsigned char* ub; int rs;
        if (isq) { ub = ws + WS_Q + ((size_t)(u.pm * 256 + wr * 64) * 1024 + head * 128 + map * 64) * 2; rs = 1024; }
        else { const int bb = rope ? (u.pm >> 4) : u.pm, s0 = rope ? LC + (u.pm & 15) * 256 : 0; ub = ws + WS_KALL + (((size_t)(bb * NH + head) * S + s0 + wr * 64) * 128 + map * 64) * 2; rs = 128; }
        const unsigned loff = (unsigned)(fr * rs + 4 * fq) * 2u;
#pragma unroll
        for (int ai = 0; ai < 2; ++ai)
#pragma unroll
            for (int m = 0; m < 4; ++m) {
                const int lr = ai * 128 + wr * 64 + m * 16 + fr;
                float ss = 0.f;
#pragma unroll
                for (int bj = 0; bj < 2; ++bj)
#pragma unroll
                    for (int n = 0; n < 2; ++n) { const f32x4 x = acc[ai][bj][m][n]; ss += (x[0] * x[0] + x[1] * x[1]) + (x[2] * x[2] + x[3] * x[3]); }
                ss += __shfl_xor(ss, 16); ss += __shfl_xor(ss, 32);
                const float rstd = gs / sqrtf(ss * (1.f / 64.f) + EPS);
                const int tpos = (u.pm & 15) * 256 + lr;
                unsigned char* rowp = ub + (size_t)((ai * 128 + m * 16) * rs * 2) + loff;
#pragma unroll
                for (int bj = 0; bj < 2; ++bj) {
                    f32x4 a = acc[ai][bj][m][0] * rstd * *(const f32x4*)(gp + 32 * bj), bq = acc[ai][bj][m][1] * rstd * *(const f32x4*)(gp + 32 * bj + 16);
                    if (rope) { const int pos = bj ? (tpos & 63) : (tpos >> 6);
                        const f32x4 c0 = *(const f32x4*)(par + PAR_ROPE + pos * 32 + 8 * fq), c1 = *(const f32x4*)(par + PAR_ROPE + pos * 32 + 8 * fq + 4);
                        const f32x4 cs = (f32x4){c0[0], c0[2], c1[0], c1[2]}, sn = (f32x4){c0[1], c0[3], c1[1], c1[3]};
                        const f32x4 a2 = a * cs - bq * sn; bq = bq * cs + a * sn; a = a2; }
                    u32x2 w0, w1; w0.x = cvt_pk_bf16(a[0], a[1]); w0.y = cvt_pk_bf16(a[2], a[3]); w1.x = cvt_pk_bf16(bq[0], bq[1]); w1.y = cvt_pk_bf16(bq[2], bq[3]);
                    *(u32x2*)(rowp + 64 * bj) = w0; *(u32x2*)(rowp + 64 * bj + 32) = w1; }
            }
    }
    __device__ __forceinline__ void operator()(const f32x4 (&acc)[2][2][4][2], const pg8::Unit& u, int wr, int wc, int fr, int fq) const {
        const int grp = u.pn >> 2, cg0 = (u.pn & 3) * 256 + wc * 32 + 8 * fq;
        if (grp == 0 || grp == 5) { qk_epi(acc, u, wr, wc, fr, fq, grp == 5); return; }
        unsigned char* ub; size_t hstride;
        { const int hd0 = (u.pn & 3) * 2;
          if (grp < 5) { const int bb = (u.kind == 0) ? (u.pm >> 4) : u.pm, s0 = (u.kind == 0) ? LC + (u.pm & 15) * 256 : 0;
              ub = ws + WS_KALL + (size_t)grp * (68 * MiB) + (((size_t)(bb * NH + hd0) * S + s0 + wr * 64) * 128 + wc * 32) * 2; hstride = (size_t)S * 256; }
          else { ub = ws + WS_QH + (((size_t)((u.pm >> 4) * NH + hd0) * T + (u.pm & 15) * 256 + wr * 64) * 128 + wc * 32) * 2; hstride = (size_t)T * 256; } }
        const unsigned loff = (unsigned)(fr * 128 + 8 * fq) * 2u;
        f32x4 lb[2][2];
        if (grp == 3 || grp == 4) {
            const float* lbp = par + (grp == 3 ? PAR_LBF : PAR_LBB) + cg0;
#pragma unroll
            for (int bj = 0; bj < 2; ++bj)
#pragma unroll
                for (int n = 0; n < 2; ++n) lb[bj][n] = *(const f32x4*)(lbp + bj * 128 + 4 * n);
        }
#pragma unroll
        for (int ai = 0; ai < 2; ++ai)
#pragma unroll
            for (int m = 0; m < 4; ++m) { unsigned char* rowp = ub + (size_t)((ai * 128 + m * 16) * 256) + loff;
#pragma unroll
                for (int bj = 0; bj < 2; ++bj) { f32x4 v0 = acc[ai][bj][m][0], v1 = acc[ai][bj][m][1]; u32x4 w;
                    if (grp == 3 || grp == 4) {
#pragma unroll
                        for (int e = 0; e < 4; ++e) { v0[e] = __logf(lb[bj][0][e] + (1.f - lb[bj][0][e]) * sigmoidf_(v0[e])); v1[e] = __logf(lb[bj][1][e] + (1.f - lb[bj][1][e]) * sigmoidf_(v1[e])); }
                        w.x = pk_f16(v0[0], v0[1]); w.y = pk_f16(v0[2], v0[3]); w.z = pk_f16(v1[0], v1[1]); w.w = pk_f16(v1[2], v1[3]);
                    } else {
                        if (grp == 6) {
#pragma unroll
                            for (int e = 0; e < 4; ++e) { v0[e] = siluf_(v0[e]); v1[e] = siluf_(v1[e]); }
                        }
                        w.x = cvt_pk_bf16(v0[0], v0[1]); w.y = cvt_pk_bf16(v0[2], v0[3]); w.z = cvt_pk_bf16(v1[0], v1[1]); w.w = cvt_pk_bf16(v1[2], v1[3]);
                    }
                    *(u32x4*)(rowp + bj * hstride) = w; } }
    }
};

namespace attn {
constexpr int LDK = 128, KVBLK = 64;
constexpr int SHM_V = KVBLK * 128 * 2, SHM_K = KVBLK * 128 * 2;
#define KSWZ(row, colB) ((row) * 256 + ((colB) ^ (((row) & 15) << 4)))
#define SBAR() __builtin_amdgcn_sched_barrier(0)
__device__ __forceinline__ int crow(int r, int hi) { return (r & 3) + 8 * (r >> 2) + 4 * hi; }
__device__ __forceinline__ void expA_(f32x16& p0) {
#pragma unroll
    for (int r = 0; r < 16; ++r) p0[r] = __builtin_amdgcn_exp2f(p0[r]);
}
template <bool NOEXP>
__device__ __forceinline__ void finishSM_(f32x16& p0, f32x16& p1, float& l_reg, bf16x8& pa0, bf16x8& pa1, bf16x8& pa2, bf16x8& pa3) {
    if constexpr (!NOEXP) {
#pragma unroll
    for (int r = 0; r < 16; ++r) p1[r] = __builtin_amdgcn_exp2f(p1[r]); }
    float ps = 0;
#pragma unroll
    for (int r = 0; r < 16; ++r) ps += p0[r];
#pragma unroll
    for (int r = 0; r < 16; ++r) ps += p1[r];
    l_reg += ps;
#define PK4(P, BASE, OUT) do { unsigned a0 = cvt_pk_bf16(P[BASE + 0], P[BASE + 1]), a1 = cvt_pk_bf16(P[BASE + 2], P[BASE + 3]);   \
    unsigned b0 = cvt_pk_bf16(P[BASE + 4], P[BASE + 5]), b1 = cvt_pk_bf16(P[BASE + 6], P[BASE + 7]);                              \
    auto r0 = __builtin_amdgcn_permlane32_swap(a0, b0, false, false); auto r1 = __builtin_amdgcn_permlane32_swap(a1, b1, false, false); \
    u32x4 w = {r0[0], r1[0], r0[1], r1[1]}; OUT = *reinterpret_cast<bf16x8*>(&w); } while (0)
    PK4(p0, 0, pa0); PK4(p0, 8, pa1); PK4(p1, 0, pa2); PK4(p1, 8, pa3);
#undef PK4
}
__device__ __forceinline__ void qkt_(f32x16& p0, f32x16& p1, const char* Ks, const bf16x8* qr, int r32, int hi, int mapcol) {
    p0 = f32x16{}; p1 = f32x16{};
#pragma unroll
    for (int d0 = 0; d0 < 4; ++d0) { const int cb = mapcol + (d0 * 16 + hi * 8) * 2;
        const bf16x8 b0 = *reinterpret_cast<const bf16x8*>(Ks + KSWZ(r32, cb));
        const bf16x8 b1 = *reinterpret_cast<const bf16x8*>(Ks + KSWZ(32 + r32, cb));
        p0 = __builtin_amdgcn_mfma_f32_32x32x16_bf16(b0, qr[d0], p0, 0, 0, 0); p1 = __builtin_amdgcn_mfma_f32_32x32x16_bf16(b1, qr[d0], p1, 0, 0, 0); }
}
__device__ __forceinline__ int v_st(int k, int c) { const int kk = (k & ~0xC) | ((k & 4) << 1) | ((k & 8) >> 1); return ((kk >> 3) * 4 + (c >> 5)) * 512 + ((kk & 7) * 32 + (c & 31)) * 2; }
__device__ __forceinline__ int v_rd_base(int lane) { return ((lane & 3) << 3) | (((lane >> 2) & 3) << 6) | (((lane >> 4) & 1) << 5) | (((lane >> 5) & 1) << 8); }
constexpr int v_rd_off(int d0, int ks, int half) { return d0 * 512 + ks * 4096 + half * 2048; }
typedef short v4i16_t __attribute__((ext_vector_type(4)));
template <int OFF> __device__ __forceinline__ s16x4 tr_read(int vb) {
    return __builtin_bit_cast(s16x4, __builtin_amdgcn_ds_read_tr16_b64_v4i16((LAS v4i16_t*)(unsigned)(vb + OFF)));
}
struct VFrag { s16x4 l0, h0, l1, h1, l2, h2, l3, h3; };
template <int D0> __device__ __forceinline__ void v_reads(VFrag& f, int vb) {
    f.l0 = tr_read<v_rd_off(D0, 0, 0)>(vb); f.h0 = tr_read<v_rd_off(D0, 0, 1)>(vb); f.l1 = tr_read<v_rd_off(D0, 1, 0)>(vb); f.h1 = tr_read<v_rd_off(D0, 1, 1)>(vb);
    f.l2 = tr_read<v_rd_off(D0, 2, 0)>(vb); f.h2 = tr_read<v_rd_off(D0, 2, 1)>(vb); f.l3 = tr_read<v_rd_off(D0, 3, 0)>(vb); f.h3 = tr_read<v_rd_off(D0, 3, 1)>(vb);
}
__device__ __forceinline__ void pv_mma(f32x16& od, const VFrag& f, bf16x8 pa0, bf16x8 pa1, bf16x8 pa2, bf16x8 pa3) {
#define PK(L, H) (bf16x8){L[0], L[1], L[2], L[3], H[0], H[1], H[2], H[3]}
    od = __builtin_amdgcn_mfma_f32_32x32x16_bf16(pa0, PK(f.l0, f.h0), od, 0, 0, 0);
    od = __builtin_amdgcn_mfma_f32_32x32x16_bf16(pa1, PK(f.l1, f.h1), od, 0, 0, 0);
    od = __builtin_amdgcn_mfma_f32_32x32x16_bf16(pa2, PK(f.l2, f.h2), od, 0, 0, 0);
    od = __builtin_amdgcn_mfma_f32_32x32x16_bf16(pa3, PK(f.l3, f.h3), od, 0, 0, 0);
#undef PK
}
__device__ __forceinline__ void pv_d0_(f32x16* o, int vb, bf16x8 pa0, bf16x8 pa1, bf16x8 pa2, bf16x8 pa3) {
    VFrag fa, fb;
    v_reads<0>(fa, vb); v_reads<1>(fb, vb);
    __builtin_amdgcn_sched_group_barrier(0x100, 16, 0);
    pv_mma(o[0], fa, pa0, pa1, pa2, pa3);
    v_reads<2>(fa, vb); pv_mma(o[1], fb, pa0, pa1, pa2, pa3);
    v_reads<3>(fb, vb); pv_mma(o[2], fa, pa0, pa1, pa2, pa3);
    pv_mma(o[3], fb, pa0, pa1, pa2, pa3);
}
__device__ __forceinline__ void glds16(const void* gsrc, unsigned lds_dst) { unsigned keep;
    asm volatile("s_mov_b32 %0, m0\n\ts_mov_b32 m0, %2\n\ts_nop 0\n\tglobal_load_lds_dwordx4 %1, off\n\ts_mov_b32 m0, %0" : "=&s"(keep) : "v"(gsrc), "s"(lds_dst) : "memory"); }
template <int ABL>
__device__ __forceinline__ void attn_unit(const bf16_t* Qb, bf16_t* Ob, const bf16_t* __restrict__ Kh, const bf16_t* __restrict__ Vh, const float lam, const float shift2, const float* __restrict__ subg, char* lds, LAS unsigned char* ldsl) {
#define qkt(P0, P1, ...) do { if constexpr (ABL & 4) { P0 = f32x16{}; P1 = f32x16{}; asm volatile("" : "+v"(P0), "+v"(P1)); } else { attn::qkt_(P0, P1, __VA_ARGS__); } } while (0)
#define expA(P0) do { if constexpr (!(ABL & 2)) attn::expA_(P0); } while (0)
#define finishSM(...) attn::finishSM_<(ABL & 2) != 0>(__VA_ARGS__)
#define pv_d0(o, vb, a0, a1, a2, a3) do { if constexpr (ABL & 1) { asm volatile("" :: "v"(a0), "v"(a1), "v"(a2), "v"(a3)); } else { attn::pv_d0_(o, vb, a0, a1, a2, a3); } } while (0)
    int tid_ = threadIdx.x; asm volatile("" : "+v"(tid_));
    const int tid = tid_, wid = __builtin_amdgcn_readfirstlane(tid >> 6), lane = tid & 63, r32 = lane & 31, hi = lane >> 5, map = wid >> 2, wq = wid & 3;
    float l_reg = 0; f32x16 o[4] = {}; bf16x8 qr[4];
    const bf16_t* Qw = Qb + (size_t)(wq * 32 + r32) * 1024 + map * 64 + hi * 8;
#pragma unroll
    for (int d0 = 0; d0 < 4; ++d0) qr[d0] = *reinterpret_cast<const bf16x8*>(Qw + d0 * 16);
    const int mapcol = map * 128;
    const int vb0 = (int)(uintptr_t)lds + v_rd_base(lane);
    constexpr int SLOT = SHM_V + SHM_K;
    unsigned ksrc[2], vsrc[2];
#pragma unroll
    for (int i = 0; i < 2; ++i) {
        { const int row = 8 * wid + 4 * i + (lane >> 4), c = (lane & 15) ^ (row & 15); ksrc[i] = (unsigned)(row * 256 + c * 16); }
        { const int sub = 4 * wid + 2 * i + (lane >> 5), kk = (sub >> 2) * 8 + ((lane >> 2) & 7), key = (kk & ~0xC) | ((kk & 4) << 1) | ((kk & 8) >> 1), c = (sub & 3) * 32 + (lane & 3) * 8;
          vsrc[i] = (unsigned)(key * 256 + c * 2); }
    }
    const unsigned ldsw = (unsigned)wid * 2048u, lds0 = (unsigned)(uintptr_t)lds;
#define DMA(t) do { if constexpr (ABL & 8) break; const char* vt_ = (const char*)Vh + (size_t)(t) * (KVBLK * LDK * 2); const char* kt_ = (const char*)Kh + (size_t)(t) * (KVBLK * LDK * 2); const unsigned so_ = (unsigned)((t) & 3) * SLOT + ldsw; \
    _Pragma("unroll") for (int i_ = 0; i_ < 2; ++i_) { \
        glds16(vt_ + vsrc[i_], (unsigned)__builtin_amdgcn_readfirstlane((int)(lds0 + so_ + i_ * 1024))); \
        glds16(kt_ + ksrc[i_], (unsigned)__builtin_amdgcn_readfirstlane((int)(lds0 + so_ + SHM_V + i_ * 1024))); } } while (0)
#define WAITBAR(N) asm volatile("s_waitcnt vmcnt(" #N ") lgkmcnt(0)\n\ts_barrier" ::: "memory")
    f32x16 pA0, pA1, pB0, pB1; bf16x8 pa0, pa1, pa2, pa3; constexpr int NT = S / KVBLK;
#define SL(t) (((t) & 3) * SLOT)
    DMA(0); DMA(1); WAITBAR(4);
    if (map == 0) {
        DMA(2); qkt(pA0, pA1, lds + SHM_V, qr, r32, hi, mapcol); expA(pA0);
#pragma unroll 1
        for (int j = 1; j + 1 < NT; j += 2) {
            WAITBAR(4); if (j + 2 < NT) DMA(j + 2);
            qkt(pB0, pB1, lds + SL(j) + SHM_V, qr, r32, hi, mapcol);
            finishSM(pA0, pA1, l_reg, pa0, pa1, pa2, pa3);
            pv_d0(o, vb0 + SL(j - 1), pa0, pa1, pa2, pa3); expA(pB0);
            if (j + 3 < NT) { WAITBAR(4); DMA(j + 3); } else { WAITBAR(0); }
            qkt(pA0, pA1, lds + SL(j + 1) + SHM_V, qr, r32, hi, mapcol);
            finishSM(pB0, pB1, l_reg, pa0, pa1, pa2, pa3);
            pv_d0(o, vb0 + SL(j), pa0, pa1, pa2, pa3); expA(pA0);
        }
        WAITBAR(0);
        qkt(pB0, pB1, lds + SL(NT - 1) + SHM_V, qr, r32, hi, mapcol);
        finishSM(pA0, pA1, l_reg, pa0, pa1, pa2, pa3);
        pv_d0(o, vb0 + SL(NT - 2), pa0, pa1, pa2, pa3); expA(pB0);
        finishSM(pB0, pB1, l_reg, pa0, pa1, pa2, pa3);
        pv_d0(o, vb0 + SL(NT - 1), pa0, pa1, pa2, pa3);
    } else {
        DMA(2); qkt(pA0, pA1, lds + SHM_V, qr, r32, hi, mapcol); expA(pA0); finishSM(pA0, pA1, l_reg, pa0, pa1, pa2, pa3);
#pragma unroll 1
        for (int j = 1; j < NT; ++j) {
            if (j + 2 < NT) { WAITBAR(4); DMA(j + 2); } else { WAITBAR(0); }
            pv_d0(o, vb0 + SL(j - 1), pa0, pa1, pa2, pa3);
            qkt(pA0, pA1, lds + SL(j) + SHM_V, qr, r32, hi, mapcol); expA(pA0);
            finishSM(pA0, pA1, l_reg, pa0, pa1, pa2, pa3);
        }
        pv_d0(o, vb0 + SL(NT - 1), pa0, pa1, pa2, pa3);
    }
#undef SL
#undef DMA
#undef WAITBAR
    { auto rr = __builtin_amdgcn_permlane32_swap(__float_as_uint(l_reg), __float_as_uint(l_reg), false, false); l_reg = __uint_as_float(rr[0]) + __uint_as_float(rr[1]); }
    const int lane_e = (int)__builtin_amdgcn_mbcnt_hi(~0u, __builtin_amdgcn_mbcnt_lo(~0u, 0u)), r32e = lane_e & 31, hie = lane_e >> 5;
    float* wsf = (float*)(lds + XS_OFF) + wid * 64;
    if (hie == 0) wsf[r32e] = l_reg;
    asm volatile("s_waitcnt lgkmcnt(0)" ::: "memory");
    float rli[16];
#pragma unroll
    for (int r = 0; r < 16; ++r) rli[r] = __builtin_amdgcn_rcpf(wsf[crow(r, hie)]);
    __syncthreads();
    float* exch = (float*)lds + (size_t)wq * 4096 + lane_e;
    if (map == 1) {
#pragma unroll
        for (int r = 0; r < 16; ++r) { const float sc2 = lam * rli[r];
#pragma unroll
            for (int d0 = 0; d0 < 4; ++d0) exch[(r * 4 + d0) * 64] = o[d0][r] * sc2; }
    }
    __syncthreads();
    if (map == 0) {
        float sg[4];
#pragma unroll
        for (int d0 = 0; d0 < 4; ++d0) sg[d0] = subg[32 * d0 + r32e] * (1.f - LAM_INIT);
#pragma unroll
        for (int r = 0; r < 16; ++r) {
            float v[4]; float ss = 0.f;
#pragma unroll
            for (int d0 = 0; d0 < 4; ++d0) { v[d0] = o[d0][r] * rli[r] - exch[(r * 4 + d0) * 64]; ss += v[d0] * v[d0]; }
            ss += __shfl_xor(ss, 1); ss += __shfl_xor(ss, 2); ss += __shfl_xor(ss, 4); ss += __shfl_xor(ss, 8); ss += __shfl_xor(ss, 16);
            const float rstd = 1.f / sqrtf(ss * (1.f / 128.f) + EPS);
            bf16_t* srow = (bf16_t*)(lds + 65536 + wq * 8704 + crow(r, hie) * 272) + r32e;
#pragma unroll
            for (int d0 = 0; d0 < 4; ++d0) srow[32 * d0] = (bf16_t)f2bf(v[d0] * rstd * sg[d0]);
        }
        asm volatile("s_waitcnt lgkmcnt(0)" ::: "memory");
#pragma unroll
        for (int i = 0; i < 8; ++i) { const int row = 4 * i + (lane_e >> 4), ch = lane_e & 15;
            const u32x4 val = *(const u32x4*)(lds + 65536 + wq * 8704 + row * 272 + ch * 16);
            *(u32x4*)(Ob + (size_t)(wq * 32 + row) * 1024 + ch * 8) = val; }
    }
    __syncthreads();
#undef qkt
#undef expA
#undef finishSM
#undef pv_d0
}
#undef KSWZ
#undef SBAR
}

namespace hg {
typedef short v4i16_t __attribute__((ext_vector_type(4)));
constexpr int PITCH = 288, APITCH = 160;
constexpr int OFF_QT = 0, OFF_KT = 64 * PITCH, OFF_VV = 2 * 64 * PITCH, OFF_ASC = 3 * 64 * PITCH, OFF_OB = OFF_ASC + 64 * APITCH, OFF_TOT = OFF_OB + 64 * PITCH, OFF_C1 = OFF_TOT + 4096, OFF_C2 = OFF_C1 + 512, OFF_D = OFF_C2 + 512, OFF_VV2 = OFF_D + 512, OFF_QST = OFF_VV2 + 64 * PITCH, OFF_END = OFF_QST + 512 * 32;
static_assert(OFF_END <= RING_BYTES, "hgrn LDS");
__device__ __forceinline__ bf16x8 trpair(const LAS unsigned char* p) {
    const s16x4 lo = __builtin_bit_cast(s16x4, __builtin_amdgcn_ds_read_tr16_b64_v4i16((LAS v4i16_t*)p));
    const s16x4 hi = __builtin_bit_cast(s16x4, __builtin_amdgcn_ds_read_tr16_b64_v4i16((LAS v4i16_t*)(p + 8 * PITCH)));
    return (bf16x8){lo[0], lo[1], lo[2], lo[3], hi[0], hi[1], hi[2], hi[3]};
}
__device__ __forceinline__ int prow(int t) { return (t & ~12) | ((t & 4) << 1) | ((t & 8) >> 1); }
constexpr int QPITCH = 272;
struct HgRegs { u32x4 ga, gb, qa, qb, va, vb; };
struct HgG { u32x4 ga, gb; };
#define HG_ROW(p) ((dir == 0) ? (p) : ((p) < LC ? (LC - 1 - (p)) : (S + LC - 1 - (p))))
template <int ABL>
__device__ __forceinline__ void hg_prefetch(HgRegs& R, const int c, const int dir, const int t0, const int oc, const unsigned short* G, const unsigned short* I, const unsigned short* QH) {
    if constexpr (ABL & 4) return;
    const int r0 = HG_ROW(c * 64 + t0), r1 = HG_ROW(c * 64 + t0 + 1);
    R.ga = __builtin_nontemporal_load((const u32x4*)(G + (size_t)r0 * 128 + 8 * oc)); R.gb = __builtin_nontemporal_load((const u32x4*)(G + (size_t)r1 * 128 + 8 * oc));
    R.va = __builtin_nontemporal_load((const u32x4*)(I + (size_t)r0 * 128 + 8 * oc)); R.vb = __builtin_nontemporal_load((const u32x4*)(I + (size_t)r1 * 128 + 8 * oc));
    { const int q0 = c >= LC / 64 ? r0 - LC : 0, q1 = c >= LC / 64 ? r1 - LC : 0;
      R.qa = __builtin_nontemporal_load((const u32x4*)(QH + (size_t)q0 * 128 + 8 * oc)); R.qb = __builtin_nontemporal_load((const u32x4*)(QH + (size_t)q1 * 128 + 8 * oc)); }
}
#define HG_BAR() asm volatile("s_waitcnt lgkmcnt(0)\n\ts_barrier" ::: "memory")
__device__ __forceinline__ void hg_prefix(const HgG& R, float (&inc)[8], float (&ex)[8], const int lg) {
#pragma unroll
    for (int ep = 0; ep < 4; ++ep) {
#pragma unroll
        for (int hh = 0; hh < 2; ++hh) { const int e = 2 * ep + hh;
            const float s = (hh ? f16hi(R.ga[ep]) : f16lo(R.ga[ep])) + (hh ? f16hi(R.gb[ep]) : f16lo(R.gb[ep]));
            const float p1 = __builtin_bit_cast(float, __builtin_amdgcn_mov_dpp(__builtin_bit_cast(int, s), 0x90, 0xf, 0xf, false));
            const float s2 = (lg >= 1) ? s + p1 : s;
            const float p2 = __builtin_bit_cast(float, __builtin_amdgcn_mov_dpp(__builtin_bit_cast(int, s2), 0x44, 0xf, 0xf, false));
            inc[e] = (lg >= 2) ? s2 + p2 : s2; ex[e] = inc[e] - s; } }
}
__device__ __forceinline__ void hg_e1(const HgG& R, LAS unsigned char* lds, const int w, const int oc, const int lg) {
    float inc[8], ex[8]; hg_prefix(R, inc, ex, lg);
    if (lg == 3) { *(LAS f32x4*)(lds + OFF_TOT + (w * 128 + 8 * oc) * 4) = (f32x4){inc[0], inc[1], inc[2], inc[3]}; *(LAS f32x4*)(lds + OFF_TOT + (w * 128 + 8 * oc + 4) * 4) = (f32x4){inc[4], inc[5], inc[6], inc[7]}; }
}
__device__ __forceinline__ void hg_e2(const HgG& R, LAS unsigned char* lds, const int tid, const int w, const int oc, const int lg, const int t0) {
    float inc[8], ex[8]; hg_prefix(R, inc, ex, lg);
    const u32x4 qa = *(const LAS u32x4*)(lds + OFF_QST + tid * 32), qb = *(const LAS u32x4*)(lds + OFF_QST + tid * 32 + 16);
    u32x4 oq0, oq1, ok0, ok1;
#pragma unroll
    for (int ep = 0; ep < 4; ++ep) {
        float cum0 = 0.f, cum1 = 0.f, off0 = 0.f, off1 = 0.f, bm0 = 0.f, bm1 = 0.f;
#pragma unroll
        for (int k = 0; k < 8; ++k) { const f32x2 t = *(const LAS f32x2*)(lds + OFF_TOT + (k * 128 + 8 * oc + 2 * ep) * 4);
            if (k == w) { off0 = cum0; off1 = cum1; } cum0 += t.x; cum1 += t.y; if (k == 3) { bm0 = cum0; bm1 = cum1; } }
        const float xa0 = f16lo(R.ga[ep]), xa1 = f16hi(R.ga[ep]), xb0 = f16lo(R.gb[ep]), xb1 = f16hi(R.gb[ep]);
        const float ba0 = off0 + ex[2 * ep] + xa0, ba1 = off1 + ex[2 * ep + 1] + xa1, bb0 = ba0 + xb0, bb1 = ba1 + xb1;
        const float eaa0 = __builtin_amdgcn_exp2f(fminf(ba0 - bm0, 80.f) * LOG2E), eaa1 = __builtin_amdgcn_exp2f(fminf(ba1 - bm1, 80.f) * LOG2E);
        const float eab0 = __builtin_amdgcn_exp2f(fminf(bb0 - bm0, 80.f) * LOG2E), eab1 = __builtin_amdgcn_exp2f(fminf(bb1 - bm1, 80.f) * LOG2E);
        const float eba0 = __builtin_amdgcn_exp2f(fminf(bm0 - ba0, 80.f) * LOG2E), eba1 = __builtin_amdgcn_exp2f(fminf(bm1 - ba1, 80.f) * LOG2E);
        const float ebb0 = __builtin_amdgcn_exp2f(fminf(bm0 - bb0, 80.f) * LOG2E), ebb1 = __builtin_amdgcn_exp2f(fminf(bm1 - bb1, 80.f) * LOG2E);
        const float ka0 = 1.f - __builtin_amdgcn_exp2f(xa0 * LOG2E), ka1 = 1.f - __builtin_amdgcn_exp2f(xa1 * LOG2E), kb0 = 1.f - __builtin_amdgcn_exp2f(xb0 * LOG2E), kb1 = 1.f - __builtin_amdgcn_exp2f(xb1 * LOG2E);
        oq0[ep] = cvt_pk_bf16(bflo(qa[ep]) * eaa0, bfhi(qa[ep]) * eaa1); oq1[ep] = cvt_pk_bf16(bflo(qb[ep]) * eab0, bfhi(qb[ep]) * eab1);
        ok0[ep] = cvt_pk_bf16(ka0 * eba0, ka1 * eba1); ok1[ep] = cvt_pk_bf16(kb0 * ebb0, kb1 * ebb1);
        if (w == 0 && lg == 0) {
            *(LAS f32x2*)(lds + OFF_C1 + (8 * oc + 2 * ep) * 4) = (f32x2){__builtin_amdgcn_exp2f(bm0 * LOG2E), __builtin_amdgcn_exp2f(bm1 * LOG2E)};
            *(LAS f32x2*)(lds + OFF_C2 + (8 * oc + 2 * ep) * 4) = (f32x2){__builtin_amdgcn_exp2f((cum0 - bm0) * LOG2E), __builtin_amdgcn_exp2f((cum1 - bm1) * LOG2E)};
            *(LAS f32x2*)(lds + OFF_D + (8 * oc + 2 * ep) * 4) = (f32x2){__builtin_amdgcn_exp2f(cum0 * LOG2E), __builtin_amdgcn_exp2f(cum1 * LOG2E)}; }
        __builtin_amdgcn_sched_barrier(0); }
    const int pt0 = prow(t0);
    *(LAS u32x4*)(lds + OFF_QT + t0 * QPITCH + 16 * oc) = oq0; *(LAS u32x4*)(lds + OFF_QT + (t0 + 1) * QPITCH + 16 * oc) = oq1;
    *(LAS u32x4*)(lds + OFF_KT + pt0 * PITCH + 16 * oc) = ok0; *(LAS u32x4*)(lds + OFF_KT + (pt0 + 1) * PITCH + 16 * oc) = ok1;
}
__device__ __forceinline__ void hg_stash(const HgRegs& RN, HgG& R, const int cn, LAS unsigned char* lds, const int tid, const int oc, const int t0) {
    const int pt0 = prow(t0), vv = (cn & 1) ? OFF_VV2 : OFF_VV;
    R.ga = RN.ga; R.gb = RN.gb;
    *(LAS u32x4*)(lds + vv + pt0 * PITCH + 16 * oc) = RN.va; *(LAS u32x4*)(lds + vv + (pt0 + 1) * PITCH + 16 * oc) = RN.vb;
    *(LAS u32x4*)(lds + OFF_QST + tid * 32) = RN.qa; *(LAS u32x4*)(lds + OFF_QST + tid * 32 + 16) = RN.qb;
}
template <int ABL>
__device__ __forceinline__ void hg_chunk(const int c, HgG& R, f32x4 (&St)[8], const int b, const int h, const int dir, unsigned short* G, const unsigned short* I, const unsigned short* QH, unsigned short* scratch, LAS unsigned char* lds,
                                         const int w, const int lane_in) {
    const bool lat = c >= LC / 64, more = c + 1 < S / 64;
    int lane = lane_in; asm volatile("" : "+v"(lane));
    int l15 = lane & 15, g = lane >> 4, q4 = l15 >> 2, p4 = lane & 3, oc = lane >> 2, lg = lane & 3, t0 = 2 * (4 * w + lg), tid = w * 64 + lane;
    HgRegs RN;
    if (c + 2 < S / 64) hg_prefetch<ABL>(RN, c + 2, dir, t0, oc, G, I, QH);
    if (more) hg_e1(R, lds, w, oc, lg);
    f32x4 o[4];
    const int trb = ((g >> 1) * 16 + (g & 1) * 4 + q4) * PITCH;
    if (lat) {
#pragma unroll 1
        for (int n = w; n < 10; n += 8) {
            const int ti = (n >= 6) ? 3 : (n >= 3) ? 2 : (n >= 1) ? 1 : 0, sj = n - (ti * (ti + 1)) / 2;
            bf16x8 ka[4], qb[4];
#pragma unroll
            for (int ks = 0; ks < 4; ++ks) { ka[ks] = *(const LAS bf16x8*)(lds + OFF_KT + (16 * sj + prow(l15)) * PITCH + (32 * ks + 8 * g) * 2); qb[ks] = *(const LAS bf16x8*)(lds + OFF_QT + (16 * ti + l15) * QPITCH + (32 * ks + 8 * g) * 2); }
            f32x4 a = (f32x4){0.f, 0.f, 0.f, 0.f};
#pragma unroll
            for (int ks = 0; ks < 4; ++ks) a = __builtin_amdgcn_mfma_f32_16x16x32_bf16(ka[ks], qb[ks], a, 0, 0, 0);
            if (sj == ti) {
#pragma unroll
                for (int r = 0; r < 4; ++r) if (4 * g + r > l15) a[r] = 0.f; }
            u32x2 pw; pw.x = cvt_pk_bf16(a[0], a[1]); pw.y = cvt_pk_bf16(a[2], a[3]);
            *(LAS u32x2*)(lds + OFF_ASC + (16 * ti + l15) * APITCH + (16 * sj + 4 * g) * 2) = pw;
        }
#define HG_LOADA(ks_, dst) do { _Pragma("unroll") for (int ti = 0; ti < 4; ++ti) { \
            const u32x2 alo_ = *(const LAS u32x2*)(lds + OFF_QT + (16 * ti + l15) * QPITCH + (32 * (ks_) + 4 * g) * 2), ahi_ = *(const LAS u32x2*)(lds + OFF_QT + (16 * ti + l15) * QPITCH + (32 * (ks_) + 16 + 4 * g) * 2); \
            dst[ti] = (u32x4){alo_.x, alo_.y, ahi_.x, ahi_.y}; } } while (0)
#pragma unroll
        for (int ks = 0; ks < 4; ++ks) {
            const f32x4 ca = *(const LAS f32x4*)(lds + OFF_C1 + (32 * ks + 4 * g) * 4), cb = *(const LAS f32x4*)(lds + OFF_C1 + (32 * ks + 16 + 4 * g) * 4);
            u32x4 aw[4];
            HG_LOADA(ks, aw);
            const f32x4 sa = St[2 * ks] * ca, sb = St[2 * ks + 1] * cb;
            u32x4 bw; bw.x = cvt_pk_bf16(sa[0], sa[1]); bw.y = cvt_pk_bf16(sa[2], sa[3]); bw.z = cvt_pk_bf16(sb[0], sb[1]); bw.w = cvt_pk_bf16(sb[2], sb[3]);
            const bf16x8 bs = __builtin_bit_cast(bf16x8, bw);
#pragma unroll
            for (int ti = 0; ti < 4; ++ti) o[ti] = __builtin_amdgcn_mfma_f32_16x16x32_bf16(__builtin_bit_cast(bf16x8, aw[ti]), bs, ks == 0 ? (f32x4){0.f, 0.f, 0.f, 0.f} : o[ti], 0, 0, 0);
        }
#undef HG_LOADA
    }
    bf16x8 vf[2];
#pragma unroll
    for (int kk = 0; kk < 2; ++kk) vf[kk] = trpair(lds + ((c & 1) ? OFF_VV2 : OFF_VV) + 32 * kk * PITCH + trb + (16 * w + 4 * p4) * 2);
#pragma unroll
    for (int blk = 0; blk < 8; ++blk) {
        f32x4 tt = (f32x4){0.f, 0.f, 0.f, 0.f};
#pragma unroll
        for (int kk = 0; kk < 2; ++kk) { const bf16x8 ka = trpair(lds + OFF_KT + 32 * kk * PITCH + trb + (16 * blk + 4 * p4) * 2);
            tt = __builtin_amdgcn_mfma_f32_16x16x32_bf16(ka, vf[kk], tt, 0, 0, 0); }
        const f32x4 dd = *(const LAS f32x4*)(lds + OFF_D + (16 * blk + 4 * g) * 4), cc = *(const LAS f32x4*)(lds + OFF_C2 + (16 * blk + 4 * g) * 4);
        St[blk] = dd * St[blk] + cc * tt;
        if (blk == 3) __builtin_amdgcn_sched_barrier(0);
    }
    asm volatile("s_waitcnt lgkmcnt(0)\n\ts_barrier" : "+v"(St[0]), "+v"(St[1]), "+v"(St[2]), "+v"(St[3]), "+v"(St[4]), "+v"(St[5]), "+v"(St[6]), "+v"(St[7]) :: "memory");
    lane = lane_in; asm volatile("" : "+v"(lane));
    l15 = lane & 15; g = lane >> 4; q4 = l15 >> 2; p4 = lane & 3; oc = lane >> 2; lg = lane & 3; t0 = 2 * (4 * w + lg); tid = w * 64 + lane;
    const int vrow = tid >> 3, vpc = tid & 7;
    if (more) hg_e2(R, lds, tid, w, oc, lg, t0);
    if (lat) {
        bf16x8 af[6];
        af[0] = *(const LAS bf16x8*)(lds + OFF_ASC + (l15) * APITCH + (8 * g) * 2); af[1] = *(const LAS bf16x8*)(lds + OFF_ASC + (16 + l15) * APITCH + (8 * g) * 2);
        af[2] = *(const LAS bf16x8*)(lds + OFF_ASC + (32 + l15) * APITCH + (8 * g) * 2); af[3] = *(const LAS bf16x8*)(lds + OFF_ASC + (32 + l15) * APITCH + (32 + 8 * g) * 2);
        af[4] = *(const LAS bf16x8*)(lds + OFF_ASC + (48 + l15) * APITCH + (8 * g) * 2); af[5] = *(const LAS bf16x8*)(lds + OFF_ASC + (48 + l15) * APITCH + (32 + 8 * g) * 2);
        o[0] = __builtin_amdgcn_mfma_f32_16x16x32_bf16(af[0], vf[0], o[0], 0, 0, 0); o[1] = __builtin_amdgcn_mfma_f32_16x16x32_bf16(af[1], vf[0], o[1], 0, 0, 0);
        o[2] = __builtin_amdgcn_mfma_f32_16x16x32_bf16(af[2], vf[0], o[2], 0, 0, 0); o[3] = __builtin_amdgcn_mfma_f32_16x16x32_bf16(af[4], vf[0], o[3], 0, 0, 0);
        o[2] = __builtin_amdgcn_mfma_f32_16x16x32_bf16(af[3], vf[1], o[2], 0, 0, 0); o[3] = __builtin_amdgcn_mfma_f32_16x16x32_bf16(af[5], vf[1], o[3], 0, 0, 0);
#pragma unroll
        for (int ti = 0; ti < 4; ++ti)
#pragma unroll
            for (int r = 0; r < 4; ++r) *(LAS unsigned short*)(lds + OFF_OB + (16 * ti + 4 * g + r) * PITCH + (16 * w + l15) * 2) = (unsigned short)f2bf(o[ti][r]);
    }
    HG_BAR();
    if (c + 2 < S / 64) hg_stash(RN, R, c + 2, lds, tid, oc, t0);
    if (lat) { const int r_ = HG_ROW(c * 64 + vrow); u32x4* d_ = scratch ? (u32x4*)(scratch + ((size_t)b * T + (r_ - LC)) * 1024 + h * 128 + vpc * 16) : (u32x4*)(G + (size_t)r_ * 128 + vpc * 16);
        __builtin_nontemporal_store(*(const LAS u32x4*)(lds + OFF_OB + vrow * PITCH + vpc * 32), d_); __builtin_nontemporal_store(*(const LAS u32x4*)(lds + OFF_OB + vrow * PITCH + vpc * 32 + 16), d_ + 1); }
}
template <int ABL>
__device__ __forceinline__ void hgrn_unit(const int b, const int h, const int dir, unsigned char* ws, LAS unsigned char* lds, unsigned short* scratch) {
    int tid_ = threadIdx.x; asm volatile("" : "+v"(tid_));
    const int tid = tid_, w = __builtin_amdgcn_readfirstlane(tid >> 6), lane = tid & 63, l15 = lane & 15, g = lane >> 4, q4 = l15 >> 2, p4 = lane & 3;
    unsigned short* G = (unsigned short*)(ws + (dir == 0 ? WS_GF : WS_GB)) + (size_t)(b * NH + h) * S * 128;
    const unsigned short* I = (const unsigned short*)(ws + WS_IALL) + (size_t)(b * NH + h) * S * 128;
    const unsigned short* QH = (const unsigned short*)(ws + WS_QH) + (size_t)(b * NH + h) * T * 128;
    f32x4 St[8];
#pragma unroll
    for (int k = 0; k < 8; ++k) St[k] = (f32x4){0.f, 0.f, 0.f, 0.f};
    { unsigned z = 0u; asm volatile("" : "+v"(z));
      for (int i = tid; i < 64 * APITCH / 16; i += 512) *(LAS u32x4*)(lds + OFF_ASC + i * 16) = (u32x4){z, z, z, z}; }
    const int oc = lane >> 2, lg = lane & 3, t0 = 2 * (4 * w + lg);
    HgRegs RA, RB;
    hg_prefetch<ABL>(RA, 0, dir, t0, oc, G, I, QH); hg_prefetch<ABL>(RB, 1, dir, t0, oc, G, I, QH);
    __syncthreads();
    HgG R;
    hg_stash(RA, R, 0, lds, tid, oc, t0);
    hg_e1(R, lds, w, oc, lg); HG_BAR(); hg_e2(R, lds, tid, w, oc, lg, t0); HG_BAR();
    hg_stash(RB, R, 1, lds, tid, oc, t0);
#pragma unroll 1
    for (int c = 0; c < S / 64; ++c) hg_chunk<ABL>(c, R, St, b, h, dir, G, I, QH, scratch, lds, w, lane);
    __syncthreads();
}
#undef HG_ROW
}


struct SchedZ {
    int G, c; const char* H; const char* W;
    __device__ __forceinline__ bool next(int i, pg8::Unit& u) const {
        const int L = i * G + c; if (L >= 128 * 12) return false;
        pg8::tile_map(L, 128, 12, u.pm, u.pn); if (u.pn >= 8) u.pn += 4;
        u.kind = 0; u.A = H + (size_t)u.pm * (256 * 1024 * 2); u.B = W + (size_t)u.pn * (256 * 1024 * 2); return true;
    }
};
struct EpiZ {
    static constexpr bool PERM = true, MID = false;
    unsigned char* ws; const float* hgain; LAS unsigned char* lds; unsigned char* outb;
    __device__ __forceinline__ void operator()(const f32x4 (&acc)[2][2][4][2], const pg8::Unit& u, int wr, int wc, int fr, int fq) const {
        const int grp = u.pn >> 2, cg0 = (u.pn & 3) * 256 + wc * 32 + 8 * fq;
        bf16_t* dst = (grp == 2 ? (bf16_t*)(outb + OUT_GA) : (bf16_t*)(ws + (grp < 2 ? WS_YA : WS_GH))) + (grp == 1 ? 1024 : 0); const int dp = grp < 2 ? 2048 : 1024;
        const int row0 = u.pm * 256 + wr * 64 + fr;
        if (grp == 1) {
            const size_t hb = ((size_t)((u.pm >> 4) * NH + (u.pn & 3) * 2) * S + LC + (u.pm & 15) * 256 + wr * 64 + fr) * 128 + wc * 32 + 8 * fq;
            const bf16_t* of = (const bf16_t*)(ws + WS_GF) + hb; const bf16_t* ob = (const bf16_t*)(ws + WS_GB) + hb;
            LAS float* xs = (LAS float*)(lds + XS_OFF);
#pragma unroll
            for (int ai = 0; ai < 2; ++ai)
#pragma unroll
                for (int m = 0; m < 4; ++m)
#pragma unroll
                    for (int bj = 0; bj < 2; ++bj) { const size_t o_ = (size_t)(ai * 128 + m * 16) * 128 + (size_t)bj * S * 128;
                        const u32x4 a = *(const u32x4*)(of + o_), b = *(const u32x4*)(ob + o_);
                        const float s0 = bflo(a.x) + bflo(b.x), s1 = bfhi(a.x) + bfhi(b.x), s2 = bflo(a.y) + bflo(b.y), s3 = bfhi(a.y) + bfhi(b.y), s4 = bflo(a.z) + bflo(b.z), s5 = bfhi(a.z) + bfhi(b.z), s6 = bflo(a.w) + bflo(b.w), s7 = bfhi(a.w) + bfhi(b.w);
                        float ss = (s0 * s0 + s1 * s1) + (s2 * s2 + s3 * s3) + (s4 * s4 + s5 * s5) + (s6 * s6 + s7 * s7);
                        ss += __shfl_xor(ss, 16); ss += __shfl_xor(ss, 32);
                        if (fq == 0) xs[((ai * 128 + wr * 64 + m * 16 + fr) * 2 + bj) * 4 + wc] = ss; }
            asm volatile("s_waitcnt lgkmcnt(0)" ::: "memory"); __builtin_amdgcn_s_barrier(); asm volatile("" ::: "memory");
            const f32x4 g0 = *(const f32x4*)(hgain + wc * 32 + 8 * fq), g1 = *(const f32x4*)(hgain + wc * 32 + 8 * fq + 4);
#pragma unroll
            for (int ai = 0; ai < 2; ++ai)
#pragma unroll
                for (int m = 0; m < 4; ++m) { const size_t off = (size_t)(row0 + ai * 128 + m * 16) * dp + cg0;
#pragma unroll
                    for (int bj = 0; bj < 2; ++bj) { const size_t o_ = (size_t)(ai * 128 + m * 16) * 128 + (size_t)bj * S * 128;
                        const f32x4 p = *(const LAS f32x4*)(xs + ((ai * 128 + wr * 64 + m * 16 + fr) * 2 + bj) * 4);
                        const float rstd = 1.f / sqrtf(((p[0] + p[1]) + (p[2] + p[3])) * (1.f / 128.f) + EPS);
                        const u32x4 a = *(const u32x4*)(of + o_), b = *(const u32x4*)(ob + o_);
                        const f32x4 v0 = acc[ai][bj][m][0], v1 = acc[ai][bj][m][1];
                        const float y0 = (bflo(a.x) + bflo(b.x)) * rstd * g0[0] * siluf_(v0[0]), y1 = (bfhi(a.x) + bfhi(b.x)) * rstd * g0[1] * siluf_(v0[1]);
                        const float y2 = (bflo(a.y) + bflo(b.y)) * rstd * g0[2] * siluf_(v0[2]), y3 = (bfhi(a.y) + bfhi(b.y)) * rstd * g0[3] * siluf_(v0[3]);
                        const float y4 = (bflo(a.z) + bflo(b.z)) * rstd * g1[0] * siluf_(v1[0]), y5 = (bfhi(a.z) + bfhi(b.z)) * rstd * g1[1] * siluf_(v1[1]);
                        const float y6 = (bflo(a.w) + bflo(b.w)) * rstd * g1[2] * siluf_(v1[2]), y7 = (bfhi(a.w) + bfhi(b.w)) * rstd * g1[3] * siluf_(v1[3]);
                        u32x4 w; w.x = cvt_pk_bf16(y0, y1); w.y = cvt_pk_bf16(y2, y3); w.z = cvt_pk_bf16(y4, y5); w.w = cvt_pk_bf16(y6, y7);
                        *(u32x4*)(dst + off + bj * 128) = w; } }
            return;
        }
        const bf16_t* src = (const bf16_t*)(ws + WS_Q);
#pragma unroll
        for (int ai = 0; ai < 2; ++ai)
#pragma unroll
            for (int m = 0; m < 4; ++m) { const size_t ioff = (size_t)(row0 + ai * 128 + m * 16) * 1024 + cg0, off = (size_t)(row0 + ai * 128 + m * 16) * dp + cg0;
#pragma unroll
                for (int bj = 0; bj < 2; ++bj) { f32x4 v0 = acc[ai][bj][m][0], v1 = acc[ai][bj][m][1];
                    if (grp == 0) { const u32x4 s = *(const u32x4*)(src + ioff + bj * 128);
                        v0[0] = siluf_(v0[0]) * bflo(s.x); v0[1] = siluf_(v0[1]) * bfhi(s.x); v0[2] = siluf_(v0[2]) * bflo(s.y); v0[3] = siluf_(v0[3]) * bfhi(s.y);
                        v1[0] = siluf_(v1[0]) * bflo(s.z); v1[1] = siluf_(v1[1]) * bfhi(s.z); v1[2] = siluf_(v1[2]) * bflo(s.w); v1[3] = siluf_(v1[3]) * bfhi(s.w);
                    } else {
#pragma unroll
                        for (int e = 0; e < 4; ++e) { v0[e] = sigmoidf_(v0[e]); v1[e] = sigmoidf_(v1[e]); }
                    }
                    u32x4 w; w.x = cvt_pk_bf16(v0[0], v0[1]); w.y = cvt_pk_bf16(v0[2], v0[3]); w.z = cvt_pk_bf16(v1[0], v1[1]); w.w = cvt_pk_bf16(v1[2], v1[3]);
                    *(u32x4*)(dst + off + bj * 128) = w; } }
    }
};
struct SchedOne {
    int pm, pn; const char* H; const char* W;
    __device__ __forceinline__ bool next(int i, pg8::Unit& u) const {
        if (i > 1) return false;
        u.pm = pm; u.pn = pn + i; u.kind = 0; u.A = H + (size_t)pm * (256 * 1024 * 2); u.B = W + (size_t)(pn + i) * (256 * 1024 * 2); return true;
    }
};
struct SchedM {
    int G, c; const char* Y; const char* WB;
    __device__ __forceinline__ bool next(int i, pg8::Unit& u) const {
        const int tile = i * G + c; if (tile >= 128 * 4) return false;
        pg8::tile_map(tile, 128, 4, u.pm, u.pn); u.kind = 0;
        u.A = Y + (size_t)u.pm * (256 * 2048 * 2); u.B = WB + (size_t)u.pn * (256 * 2048 * 2); return true;
    }
};
struct EpiM {
    static constexpr bool PERM = true, MID = true;
    unsigned char* ws; unsigned char* outb;
    __device__ __forceinline__ void mid(f32x4 (&acc)[2][2][4][2], const pg8::Unit& u, int wr, int wc, int fr, int fq) const {
        const size_t ubo = ((size_t)(u.pm * 256 + wr * 64) * 1024 + u.pn * 256 + wc * 32) * 2; unsigned loff = (unsigned)(fr * 1024 + 8 * fq) * 2u;
        asm volatile("" : "+v"(loff));
        const unsigned char* ga = outb + OUT_GA + ubo; const unsigned char* gh = ws + WS_GH + ubo;
#pragma unroll
        for (int ai = 0; ai < 2; ++ai)
#pragma unroll
            for (int m = 0; m < 4; ++m) { const unsigned char* gar = ga + (size_t)((ai * 128 + m * 16) * 2048); const unsigned char* ghr = gh + (size_t)((ai * 128 + m * 16) * 2048);
#pragma unroll
                for (int bj = 0; bj < 2; ++bj) { const u32x4 a = *(const u32x4*)(gar + bj * 256 + loff), h = *(const u32x4*)(ghr + bj * 256 + loff);
                    f32x4& v0 = acc[ai][bj][m][0]; f32x4& v1 = acc[ai][bj][m][1];
                    v0[0] *= bflo(a.x) * __builtin_amdgcn_rcpf(bflo(h.x)); v0[1] *= bfhi(a.x) * __builtin_amdgcn_rcpf(bfhi(h.x)); v0[2] *= bflo(a.y) * __builtin_amdgcn_rcpf(bflo(h.y)); v0[3] *= bfhi(a.y) * __builtin_amdgcn_rcpf(bfhi(h.y));
                    v1[0] *= bflo(a.z) * __builtin_amdgcn_rcpf(bflo(h.z)); v1[1] *= bfhi(a.z) * __builtin_amdgcn_rcpf(bfhi(h.z)); v1[2] *= bflo(a.w) * __builtin_amdgcn_rcpf(bflo(h.w)); v1[3] *= bfhi(a.w) * __builtin_amdgcn_rcpf(bfhi(h.w)); }
                asm volatile("" ::: "memory"); }
    }
    __device__ __forceinline__ void operator()(const f32x4 (&acc)[2][2][4][2], const pg8::Unit& u, int wr, int wc, int fr, int fq) const {
        const size_t ubo = ((size_t)(u.pm * 256 + wr * 64) * 1024 + u.pn * 256 + wc * 32) * 2; unsigned loff = (unsigned)(fr * 1024 + 8 * fq) * 2u;
        asm volatile("" : "+v"(loff));
        const unsigned char* gate = ws + WS_GH + ubo; unsigned char* mm = ws + WS_MM + ubo;
#pragma unroll
        for (int ai = 0; ai < 2; ++ai)
#pragma unroll
            for (int m = 0; m < 4; ++m) { const unsigned char* gr = gate + (size_t)((ai * 128 + m * 16) * 2048); unsigned char* mr = mm + (size_t)((ai * 128 + m * 16) * 2048);
#pragma unroll
                for (int bj = 0; bj < 2; ++bj) { f32x4 v0 = acc[ai][bj][m][0], v1 = acc[ai][bj][m][1]; const u32x4 g = *(const u32x4*)(gr + bj * 256 + loff);
                    v0[0] *= bflo(g.x); v0[1] *= bfhi(g.x); v0[2] *= bflo(g.y); v0[3] *= bfhi(g.y); v1[0] *= bflo(g.z); v1[1] *= bfhi(g.z); v1[2] *= bflo(g.w); v1[3] *= bfhi(g.w);
                    u32x4 w; w.x = cvt_pk_bf16(v0[0], v0[1]); w.y = cvt_pk_bf16(v0[2], v0[3]); w.z = cvt_pk_bf16(v1[0], v1[1]); w.w = cvt_pk_bf16(v1[2], v1[3]);
                    *(u32x4*)(mr + bj * 256 + loff) = w; } }
    }
};
struct SchedO {
    int G, c; const char* MMp; const char* W;
    __device__ __forceinline__ bool next(int i, pg8::Unit& u) const {
        const int L = i * G + c; if (L >= 128 * 4) return false;
        pg8::tile_map(L, 128, 4, u.pm, u.pn); u.kind = 0; u.A = MMp + (size_t)u.pm * (256 * 1024 * 2); u.B = W + (size_t)u.pn * (256 * 1024 * 2); return true;
    }
};
struct EpiOut {
    static constexpr bool PERM = false, MID = false;
    const float* x; float* out; const float* par;
    __device__ __forceinline__ void operator()(const f32x4 (&acc)[2][2][4][2], const pg8::Unit& u, int wr, int wc, int fr, int fq) const {
        const int row0 = u.pm * 256 + wr * 64 + fr, col0 = u.pn * 256 + wc * 32 + 4 * fq;
        const float* gp = par + PAR_MOD + (u.pm >> 4) * 3072 + 2048 + col0;
        f32x4 gv[2][2];
#pragma unroll
        for (int bj = 0; bj < 2; ++bj)
#pragma unroll
            for (int n = 0; n < 2; ++n) gv[bj][n] = *(const f32x4*)(gp + bj * 128 + n * 16);
#pragma unroll
        for (int ai = 0; ai < 2; ++ai)
#pragma unroll
            for (int m = 0; m < 4; ++m) { const size_t off = (size_t)(row0 + ai * 128 + m * 16) * 1024 + col0;
#pragma unroll
                for (int bj = 0; bj < 2; ++bj)
#pragma unroll
                    for (int n = 0; n < 2; ++n) { const f32x4 xv = *(const f32x4*)(x + off + bj * 128 + n * 16); *(f32x4*)(out + off + bj * 128 + n * 16) = xv + gv[bj][n] * acc[ai][bj][m][n]; } }
    }
};

constexpr int CW_QUEUE = 8192;
__device__ __forceinline__ void mix_phase(Frame& F, volatile LAS unsigned* MISC) {
    const float lam = F.par[PAR_SCAL], shift2 = F.par[PAR_SCAL + 1];
    const int x = (F.G == 256) ? (F.vcu >> 5) : 0, nq = (F.G == 256) ? 8 : 1;
    unsigned* ctr = (unsigned*)(F.ws + WS_CTL) + CW_QUEUE + 64 * x;
    const int n_h = 128 / nq, n_a = 2048 / nq, n_g = 256 / nq;
    for (;;) {
        if (F.tid == 0) MISC[16] = __hip_atomic_fetch_add(ctr, 1u, __ATOMIC_RELAXED, __HIP_MEMORY_SCOPE_AGENT);
        __syncthreads();
        const int item = __builtin_amdgcn_readfirstlane((int)MISC[16]);
        __syncthreads();
        if (item >= n_h + n_a + n_g) break;
        if (item < n_h) { const int u = item * nq + x;
#if defined(REP_HG)
            hg::hgrn_unit<REP_HG - 1>(u >> 4, (u >> 1) & 7, u & 1, F.ws, F.lds, (unsigned short*)(F.outb + OUT_YH));
#endif
            hg::hgrn_unit<0>(u >> 4, (u >> 1) & 7, u & 1, F.ws, F.lds, nullptr); }
        else if (item >= n_h + n_a) { const int gi = (item - n_h - n_a) * nq + x;
            SchedOne Sc{gi >> 1, 8 + 2 * (gi & 1), (const char*)(F.outb + OUT_H), (const char*)(F.ws + WS_WIN + (size_t)7168 * 1024 * 2)};
            EpiZ E{F.ws, F.in[IN_HG], F.lds, F.outb};
            pg8::gemm_phase<EpiZ, SchedOne, true, true>(F.lds, D, Sc, E); }
        else { const int a = item - n_h, bh = (a >> 5) * nq + x, qb = a & 31, b = bh >> 3, h = bh & 7;
            const size_t qoff = ((size_t)b * T + (size_t)qb * 128) * 1024 + h * 128;
            const bf16_t* Qb = (const bf16_t*)(F.ws + WS_Q) + qoff; bf16_t* Ob = (bf16_t*)(F.ws + WS_Q) + qoff;
            const bf16_t* Kh = (const bf16_t*)(F.ws + WS_KALL) + (size_t)bh * S * 128;
            const bf16_t* Vh = (const bf16_t*)(F.ws + WS_VALL) + (size_t)bh * S * 128;
#if defined(REP_ATT)
            attn::attn_unit<REP_ATT - 1>(Qb, (bf16_t*)(F.outb + OUT_YH) + qoff, Kh, Vh, lam, shift2, F.in[IN_SUBG], (char*)F.ldsg, F.lds);
#endif
            attn::attn_unit<0>(Qb, Ob, Kh, Vh, lam, shift2, F.in[IN_SUBG], (char*)F.ldsg, F.lds); }
    }
}

constexpr int N_PHASES = 9;
__global__ void __launch_bounds__(512, 2) mega_fwd(Args args) {
    extern __shared__ __attribute__((aligned(16))) unsigned char lds[];
    Frame F;
    F.lds = (LAS unsigned char*)lds; F.ldsg = lds;
    F.tid = threadIdx.x; F.lane = F.tid & 63; F.wave = __builtin_amdgcn_readfirstlane(F.tid >> 6);
    F.G = gridDim.x; { const int bx = blockIdx.x; F.vcu = (F.G % 8 == 0) ? (bx % 8) * (F.G / 8) + bx / 8 : bx; }
#pragma unroll
    for (int i = 0; i < 21; ++i) F.in[i] = args.in[i];
    F.ws = args.ws; F.outb = (unsigned char*)args.out; F.par = (float*)(args.ws + WS_PAR);
    volatile LAS unsigned* MISC = (volatile LAS unsigned*)(F.lds + MISC_OFF);
    for (int u = F.tid; u < (LDS_BYTES - LDSCTL_OFF) / 4; u += 512) ((LAS unsigned*)(F.lds + LDSCTL_OFF))[u] = 0u;
    __syncthreads();
    XcdBarrier bar; bar.bar = (unsigned*)(args.ws + WS_CTL) + CW_BAR; bar.x = 0; bar.st = nullptr;
    if (MK_ONE_LAUNCH) bar = xcd_barrier_post((unsigned*)(args.ws + WS_CTL) + CW_BAR, MISC + 8);
    const int lo = args.ph_lo, hi = args.ph_hi;
#ifndef REPEAT_MASK
#define REPEAT_MASK 0
#endif
#ifndef PH_MASK
#define PH_MASK 0x1ff
#endif
#define IN(k) (((PH_MASK >> (k)) & 1) && lo <= (k) && (k) < hi)
#define REP(k) (((REPEAT_MASK >> (k)) & 1) ? 2 : 1)
#define SEAM(k) do { if (IN(k) && IN((k) + 1)) xcd_barrier(bar); } while (0)
    if (IN(0)) for (int rep_ = 0; rep_ < REP(0); ++rep_) { p0a(F); __syncthreads(); } SEAM(0);
    if (IN(1)) for (int rep_ = 0; rep_ < REP(1); ++rep_) { p0b(F); p0_weights(F); __syncthreads(); } SEAM(1);
#if defined(REP_P1)
    if (IN(2)) { SchedIn Sc{F.G, (int)blockIdx.x, (const char*)(F.outb + OUT_H), (const char*)(F.ws + WS_HC), (const char*)(F.ws + WS_WIN)};
        EpiProbe<REP_P1> E{F.outb + OUT_YH};
        pg8::gemm_phase<EpiProbe<REP_P1>, SchedIn, true, true>(F.lds, D, Sc, E); }
#endif
    if (IN(2)) for (int rep_ = 0; rep_ < REP(2); ++rep_) {
        SchedIn Sc{F.G, (int)blockIdx.x, (const char*)(F.outb + OUT_H), (const char*)(F.ws + WS_HC), (const char*)(F.ws + WS_WIN)};
        EpiIn E{F.ws, F.par, F.in[IN_KG], F.in[IN_QG]};
        pg8::gemm_phase<EpiIn, SchedIn, true, true>(F.lds, D, Sc, E);
    } SEAM(2);
    if (IN(4)) { mix_phase(F, MISC); } SEAM(4);
    if (IN(6)) for (int rep_ = 0; rep_ < REP(6); ++rep_) {
        SchedZ Sc{F.G, (int)blockIdx.x, (const char*)(F.outb + OUT_H), (const char*)(F.ws + WS_WIN + (size_t)7168 * 1024 * 2)};
        EpiZ E{F.ws, F.in[IN_HG], F.lds, F.outb};
        pg8::gemm_phase<EpiZ, SchedZ, true, true>(F.lds, D, Sc, E);
    } SEAM(6);
    if (IN(7)) for (int rep_ = 0; rep_ < REP(7); ++rep_) {
        SchedM Sc{F.G, (int)blockIdx.x, (const char*)(F.ws + WS_YA), (const char*)(F.ws + WS_WBA)};
        EpiM E{F.ws, F.outb};
        pg8::gemm_phase<EpiM, SchedM, true, true>(F.lds, 2 * D, Sc, E);
    } SEAM(7);
    if (IN(8)) for (int rep_ = 0; rep_ < REP(8); ++rep_) {
        SchedO Sc{F.G, (int)blockIdx.x, (const char*)(F.ws + WS_MM), (const char*)(F.ws + WS_WO)};
        EpiOut E{F.in[IN_X], args.out, F.par};
        pg8::gemm_phase<EpiOut, SchedO, true, true>(F.lds, D, Sc, E);
    }
#undef IN
#undef SEAM
}

extern "C" void kernel_launch(void* const* d_in, const int* in_sizes, int n_in, void* d_out, int out_size, void* d_ws, size_t ws_size, hipStream_t stream) {
    static int grid = 0;
    if (grid == 0) {
        if (n_in != 21 || in_sizes[0] != M * D || out_size != M * D || ws_size < WS_END) { fprintf(stderr, "kernel_launch: unexpected shapes: n_in %d in0 %d out %d ws %zu (need %zu)\n", n_in, n_in > 0 ? in_sizes[0] : -1, out_size, ws_size, (size_t)WS_END); grid = -1; return; }
        int dev = 0, cus = 0, per_cu = 0;
        if (hipGetDevice(&dev) != hipSuccess || hipDeviceGetAttribute(&cus, hipDeviceAttributeMultiprocessorCount, dev) != hipSuccess) { grid = -1; return; }
        if (hipFuncSetAttribute((const void*)mega_fwd, hipFuncAttributeMaxDynamicSharedMemorySize, LDS_BYTES) != hipSuccess) { fprintf(stderr, "kernel_launch: hipFuncSetAttribute failed\n"); grid = -1; return; }
        if (hipOccupancyMaxActiveBlocksPerMultiprocessor(&per_cu, (const void*)mega_fwd, 512, LDS_BYTES) != hipSuccess || per_cu < 1) fprintf(stderr, "kernel_launch: occupancy query reports %d\n", per_cu);
        (void)hipGetLastError();
        grid = cus;
        if (grid != 256) fprintf(stderr, "kernel_launch: %d CUs; this build assumes 256\n", grid);
    }
    if (grid < 0) return;
    (void)hipMemsetAsync((char*)d_ws + WS_CTL, 0, CTL_ZERO_BYTES, stream);
    Args a{};
    for (int i = 0; i < 21; ++i) a.in[i] = (const float*)d_in[i];
    a.out = (float*)d_out; a.ws = (unsigned char*)d_ws;
    if (MK_ONE_LAUNCH) { a.ph_lo = 0; a.ph_hi = N_PHASES; hipLaunchKernelGGL(mega_fwd, dim3(grid), dim3(512), LDS_BYTES, stream, a); }
    else for (int p = 0; p < N_PHASES; ++p) { a.ph_lo = p; a.ph_hi = p + 1; hipLaunchKernelGGL(mega_fwd, dim3(grid), dim3(512), LDS_BYTES, stream, a); }
    const hipError_t le = hipPeekAtLastError();
    if (le != hipSuccess) fprintf(stderr, "kernel_launch: launch failed: %s\n", hipGetErrorName(le));
}
```

```cpp
#include <hip/hip_runtime.h>
#include <cstdio>
#include <cstdint>

#ifndef MK_ONE_LAUNCH
#define MK_ONE_LAUNCH 1
#endif

constexpr int NB = 8, T = 4096, D = 1024, LC = 256, S = LC + T, M = NB * T, MC = NB * LC, MALL = NB * S;
constexpr int NH = 8;
constexpr int NIN = 11264;
constexpr float EPS = 1e-6f;
constexpr float LAM_INIT = 0.2f;
constexpr float LOG2E = 1.4426950408889634f;

#define GAS __attribute__((address_space(1)))
#define LAS __attribute__((address_space(3)))
typedef unsigned short bf16_t;
typedef short bf16x8 __attribute__((ext_vector_type(8)));
typedef short s16x4 __attribute__((ext_vector_type(4)));
typedef float f32x4 __attribute__((ext_vector_type(4)));
typedef float f32x2 __attribute__((ext_vector_type(2)));
typedef float f32x16 __attribute__((ext_vector_type(16)));
typedef unsigned u32x4 __attribute__((ext_vector_type(4)));
typedef unsigned u32x2 __attribute__((ext_vector_type(2)));
typedef GAS unsigned gu32;

constexpr size_t MiB = 1u << 20;
constexpr size_t WS_CTL = 0, CTL_ZERO_BYTES = 64 * 1024;
constexpr size_t WS_PAR = 1 * MiB;
constexpr size_t WS_WIN = 2 * MiB;
constexpr size_t WS_WBA = 24 * MiB, WS_WBH = 26 * MiB, WS_WO = 28 * MiB;
constexpr size_t WS_HC = 30 * MiB;
constexpr size_t WS_KALL = 34 * MiB, WS_VALL = 102 * MiB, WS_IALL = 170 * MiB, WS_GF = 238 * MiB, WS_GB = 306 * MiB;
constexpr size_t WS_Q = 374 * MiB, WS_QH = 438 * MiB;
constexpr size_t WS_END = 502 * MiB;
constexpr size_t WS_YA = 34 * MiB, WS_YHH = 98 * MiB, WS_GA = 162 * MiB, WS_GH = 438 * MiB, WS_MM = 290 * MiB;
constexpr size_t BATCH_KV_BYTES = (size_t)NH * S * 128 * 2;
__host__ __device__ __forceinline__ size_t ya_panel_off(int pm) { const int b = pm >> 4, p = pm & 15; return (p < 8 ? WS_KALL : WS_VALL) + (size_t)b * BATCH_KV_BYTES + (size_t)(p & 7) * MiB; }
__host__ __device__ __forceinline__ size_t mm_panel_off(int pm) { const int b = pm >> 4, p = pm & 15; return WS_IALL + (size_t)b * BATCH_KV_BYTES + (size_t)p * (512 * 1024); }
constexpr size_t OUT_H = 0, OUT_YH = 64 * MiB, OUT_GA = 64 * MiB;
constexpr int PAR_MOD = 0;
constexpr int PAR_LBF = 9 * 3072, PAR_LBB = PAR_LBF + 1024;
constexpr int PAR_ROPE = PAR_LBB + 1024;
constexpr int PAR_SCAL = PAR_ROPE + 2048;
constexpr int CW_BAR = 4096;

constexpr int RING_BYTES = 131072;
constexpr int LDSCTL_OFF = RING_BYTES, MISC_OFF = LDSCTL_OFF + 320;
constexpr int LDS_BYTES = 147456;
constexpr int XS_OFF = 136 * 1024;

#define LDS_WAIT() asm volatile("s_waitcnt lgkmcnt(0)" ::: "memory")
#define VM_WAIT() asm volatile("s_waitcnt vmcnt(0)" ::: "memory")
__device__ __forceinline__ unsigned f2bf(float f) { unsigned u = __builtin_bit_cast(unsigned, f); return (u + 0x7fffu + ((u >> 16) & 1u)) >> 16; }
__device__ __forceinline__ unsigned pk2(float lo, float hi) { return f2bf(lo) | (f2bf(hi) << 16); }
__device__ __forceinline__ float bf2f(unsigned short b) { return __builtin_bit_cast(float, (unsigned)b << 16); }
__device__ __forceinline__ float bflo(unsigned w) { return __builtin_bit_cast(float, w << 16); }
__device__ __forceinline__ float bfhi(unsigned w) { return __builtin_bit_cast(float, w & 0xffff0000u); }
typedef float f32x2_t_ __attribute__((ext_vector_type(2))); typedef __bf16 bf16x2_t_ __attribute__((ext_vector_type(2)));
__device__ __forceinline__ unsigned cvt_pk_bf16(float lo, float hi) { unsigned r; asm volatile("v_cvt_pk_bf16_f32 %0, %1, %2" : "=v"(r) : "v"(lo), "v"(hi)); return r; }
__device__ __forceinline__ unsigned cvt_pk_bf16_t(float lo, float hi) { const f32x2_t_ v = {lo, hi}; const bf16x2_t_ b = __builtin_convertvector(v, bf16x2_t_); return __builtin_bit_cast(unsigned, b); }
__device__ __forceinline__ unsigned pk_f16(float lo, float hi) { _Float16 a = (_Float16)lo, b = (_Float16)hi; return (unsigned)__builtin_bit_cast(unsigned short, a) | ((unsigned)__builtin_bit_cast(unsigned short, b) << 16); }
__device__ __forceinline__ float f16lo(unsigned w) { return (float)__builtin_bit_cast(_Float16, (unsigned short)(w & 0xffffu)); }
__device__ __forceinline__ float f16hi(unsigned w) { return (float)__builtin_bit_cast(_Float16, (unsigned short)(w >> 16)); }
__device__ __forceinline__ float sigmoidf_(float v) { return __builtin_amdgcn_rcpf(1.f + __builtin_amdgcn_exp2f(-v * LOG2E)); }
__device__ __forceinline__ float siluf_(float v) { return v * sigmoidf_(v); }
__device__ __forceinline__ float wave_sum(float v) {
#pragma unroll
    for (int o = 1; o < 64; o <<= 1) v += __shfl_xor(v, o);
    return v;
}

namespace pg8 {
constexpr int BM = 256, BK = 64, HALF = 128, HTB = HALF * BK * 2, STAGE_BYTES = 8 * HTB, NXCD = 8, WGM = 4;
__host__ __device__ __forceinline__ int lds_byte(int r, int c) { const int st = (r >> 4) * 2 + (c >> 5), rr = r & 15, cc = c & 31, ob = rr * 64 + cc * 2; return st * 1024 + (ob ^ (((ob >> 9) & 1) << 5)); }
__host__ __device__ __forceinline__ void stage_rc(int b, int& R, int& C) { const int st = b / 1024, sb = b % 1024, swz = sb ^ (((sb >> 9) & 1) << 5); R = (st >> 1) * 16 + swz / 64; C = (st & 1) * 32 + (swz % 64) / 2; }
__host__ __device__ __forceinline__ int perm32(int rho) { const int n = rho >> 4, i = rho & 15; return 8 * (i >> 2) + 4 * n + (i & 3); }

struct Unit { int pm, pn, kind; const char* A; const char* B; };

__device__ __forceinline__ void tile_map(int wgid_in, int nM, int nN, int& pm, int& pn) {
    const int nwg = nM * nN; int wgid = wgid_in;
    { const int q = nwg / NXCD, r = nwg % NXCD, xcd = wgid % NXCD, off = wgid / NXCD; wgid = (xcd < r ? xcd * (q + 1) : r * (q + 1) + (xcd - r) * q) + off; }
    const int nig = WGM * nN, gid = wgid / nig, fm = gid * WGM, gsz = (nM - fm) < WGM ? (nM - fm) : WGM;
    pm = fm + ((wgid % nig) % gsz); pn = (wgid % nig) / gsz;
}

template <class Epi, class Sched, bool ALIGN_EPI, bool SP2>
__device__ __forceinline__ void gemm_phase(LAS unsigned char* lds, const int K, const Sched& S, const Epi& E) {
    int tid_ = threadIdx.x; asm volatile("" : "+v"(tid_));
    const int tid = tid_, wid = __builtin_amdgcn_readfirstlane(tid >> 6), lane = tid & 63, wr = wid >> 2, wc = wid & 3, fr = lane & 15, fq = lane >> 4;
    const int nt = K / BK;
    unsigned voffA[2], voffB[2];
#pragma unroll
    for (int i = 0; i < 2; ++i) { int R, C; stage_rc(tid * 16 + i * 8192, R, C); const int Rb = Epi::PERM ? ((R & ~31) + perm32(R & 31)) : R;
        voffA[i] = (unsigned)(R * K + C) * 2u; voffB[i] = (unsigned)(Rb * K + C) * 2u; }
    const size_t kstep = (size_t)(BK * 2);
    const size_t hstep = (size_t)HALF * K * 2;
    const unsigned ldsw = (unsigned)wid * 1024u;
    const int aoff = lds_byte(wr * 64 + fr, fq * 8), boff = lds_byte(wc * 32 + fr, fq * 8);
#define PG8_SA(b, h) (((b) * 2 + (h)) * HTB)
#define PG8_SB(b, h) ((4 + (b) * 2 + (h)) * HTB)
#define PG8_STAGE(bufoff, gbase, voff) do { _Pragma("unroll") for (int _i = 0; _i < 2; ++_i) \
        __builtin_amdgcn_global_load_lds((const unsigned*)((const char*)(gbase) + (voff)[_i]), (LAS unsigned*)(lds + (bufoff) + ldsw + _i * 8192), 16, 0, 0); } while (0)
#define PG8_LDA(dst, b, h) do { _Pragma("unroll") for (int m = 0; m < 4; ++m) _Pragma("unroll") for (int k = 0; k < 2; ++k) dst[m][k] = *(const LAS bf16x8*)(lds + PG8_SA(b, h) + aoff + m * 2048 + k * 1024); } while (0)
#define PG8_LDB(dst, b, h) do { _Pragma("unroll") for (int n = 0; n < 2; ++n) _Pragma("unroll") for (int k = 0; k < 2; ++k) dst[n][k] = *(const LAS bf16x8*)(lds + PG8_SB(b, h) + boff + n * 2048 + k * 1024); } while (0)
#define PG8_MMA(ai, bj, At, Bt) do { __builtin_amdgcn_s_setprio(1); _Pragma("unroll") for (int m = 0; m < 4; ++m) _Pragma("unroll") for (int n = 0; n < 2; ++n) _Pragma("unroll") for (int k = 0; k < 2; ++k) \
        acc[ai][bj][m][n] = __builtin_amdgcn_mfma_f32_16x16x32_bf16(Bt[n][k], At[m][k], acc[ai][bj][m][n], 0, 0, 0); __builtin_amdgcn_s_setprio(0); } while (0)
#define PG8_WAIT_V(n) asm volatile("s_waitcnt vmcnt(" #n ")" ::: "memory")
#define PG8_WAIT_L(n) asm volatile("s_waitcnt lgkmcnt(" #n ")" ::: "memory")
#define PG8_BAR __builtin_amdgcn_s_barrier()
#define PG8_SCHED __builtin_amdgcn_sched_barrier(0)
    Unit cur, nxt; int ui = 0;
    if (!S.next(0, cur)) return;
    f32x4 acc[2][2][4][2];
#pragma unroll
    for (int a = 0; a < 2; ++a)
#pragma unroll
        for (int b = 0; b < 2; ++b)
#pragma unroll
            for (int m = 0; m < 4; ++m)
#pragma unroll
                for (int n = 0; n < 2; ++n) acc[a][b][m][n] = (f32x4){0.f, 0.f, 0.f, 0.f};
    bf16x8 At[4][2], B0[2][2], B1[2][2];
    const char* cA = cur.A; const char* cB = cur.B;
    if constexpr (SP2) {
        PG8_STAGE(PG8_SB(0, 0), cB, voffB); PG8_STAGE(PG8_SB(0, 1), cB + hstep, voffB); PG8_STAGE(PG8_SA(0, 0), cA, voffA); PG8_STAGE(PG8_SA(0, 1), cA + hstep, voffA);
        if (wr == 1) PG8_BAR;
        PG8_WAIT_V(2); PG8_BAR;
        PG8_STAGE(PG8_SB(1, 0), cB + kstep, voffB); PG8_STAGE(PG8_SA(1, 0), cA + kstep, voffA); PG8_STAGE(PG8_SB(1, 1), cB + hstep + kstep, voffB);
        PG8_WAIT_V(0); PG8_BAR;
    } else {
        PG8_STAGE(PG8_SB(0, 0), cB, voffB); PG8_STAGE(PG8_SA(0, 0), cA, voffA); PG8_STAGE(PG8_SB(0, 1), cB + hstep, voffB); PG8_STAGE(PG8_SA(0, 1), cA + hstep, voffA);
        if (wr == 1) PG8_BAR;
        PG8_WAIT_V(4); PG8_BAR;
        PG8_STAGE(PG8_SB(1, 0), cB + kstep, voffB); PG8_STAGE(PG8_SA(1, 0), cA + kstep, voffA); PG8_STAGE(PG8_SB(1, 1), cB + hstep + kstep, voffB);
        PG8_WAIT_V(6); PG8_BAR;
    }
    for (;;) {
        const bool has_next = S.next(ui + 1, nxt);
        const char* nA = has_next ? nxt.A : cA; const char* nB = has_next ? nxt.B : cB;
        for (int t = 0; t < nt; t += 2) {
            if constexpr (Epi::MID) { if (t == nt / 2) E.mid(acc, cur, wr, wc, fr, fq); }
            const bool last = (t == nt - 2);
            const char* a1 = cA + (size_t)(t + 1) * kstep;
            const char* a2 = last ? nA : cA + (size_t)(t + 2) * kstep; const char* b2 = last ? nB : cB + (size_t)(t + 2) * kstep;
            const char* a3 = a2 + kstep; const char* b3 = b2 + kstep;
            if constexpr (SP2) {
#define PG8_WAIT_V12() do { if constexpr (Epi::STORES16) asm volatile("s_cmp_eq_u32 %0, 0\n\ts_cbranch_scc1 1f\n\ts_waitcnt vmcnt(8)\n1:\n\ts_waitcnt vmcnt(24)" :: "s"(t) : "memory", "scc"); else PG8_WAIT_V(8); } while (0)
            PG8_LDB(B0, 0, 0); PG8_LDB(B1, 0, 1); PG8_SCHED; PG8_LDA(At, 0, 0); PG8_STAGE(PG8_SA(1, 1), a1 + hstep, voffA);
            PG8_WAIT_V12(); PG8_WAIT_L(0); PG8_BAR; PG8_MMA(0, 0, At, B0); PG8_MMA(0, 1, At, B1); PG8_BAR; PG8_SCHED;
            PG8_LDA(At, 0, 1); PG8_STAGE(PG8_SB(0, 0), b2, voffB); PG8_STAGE(PG8_SB(0, 1), b2 + hstep, voffB); PG8_STAGE(PG8_SA(0, 0), a2, voffA);
            PG8_WAIT_V12(); PG8_WAIT_L(0); PG8_BAR; PG8_MMA(1, 0, At, B0); PG8_MMA(1, 1, At, B1); PG8_BAR; PG8_SCHED;
            PG8_LDB(B0, 1, 0); PG8_LDB(B1, 1, 1); PG8_SCHED; PG8_LDA(At, 1, 0); PG8_STAGE(PG8_SA(0, 1), a2 + hstep, voffA);
            PG8_WAIT_V(8); PG8_WAIT_L(0); PG8_BAR; PG8_MMA(0, 0, At, B0); PG8_MMA(0, 1, At, B1); PG8_BAR; PG8_SCHED;
            PG8_LDA(At, 1, 1); PG8_STAGE(PG8_SB(1, 0), b3, voffB); PG8_STAGE(PG8_SB(1, 1), b3 + hstep, voffB); PG8_STAGE(PG8_SA(1, 0), a3, voffA);
            PG8_WAIT_V(8); PG8_WAIT_L(0); PG8_BAR; PG8_MMA(1, 0, At, B0); PG8_MMA(1, 1, At, B1); PG8_BAR; PG8_SCHED;
            } else {
            PG8_LDB(B0, 0, 0); PG8_SCHED; PG8_LDA(At, 0, 0); PG8_STAGE(PG8_SA(1, 1), a1 + hstep, voffA);
            PG8_WAIT_L(8); PG8_BAR; PG8_WAIT_L(0); PG8_MMA(0, 0, At, B0); PG8_BAR; PG8_SCHED;
            PG8_LDB(B1, 0, 1); PG8_STAGE(PG8_SB(0, 0), b2, voffB);
            PG8_BAR; PG8_WAIT_L(0); PG8_MMA(0, 1, At, B1); PG8_BAR;
            PG8_LDA(At, 0, 1); PG8_STAGE(PG8_SA(0, 0), a2, voffA);
            PG8_BAR; PG8_WAIT_L(0); PG8_MMA(1, 0, At, B0); PG8_BAR; PG8_SCHED;
            PG8_STAGE(PG8_SB(0, 1), b2 + hstep, voffB);
            PG8_WAIT_V(6); PG8_BAR; PG8_MMA(1, 1, At, B1); PG8_BAR;
            PG8_LDB(B0, 1, 0); PG8_SCHED; PG8_LDA(At, 1, 0); PG8_STAGE(PG8_SA(0, 1), a2 + hstep, voffA);
            PG8_WAIT_L(8); PG8_BAR; PG8_WAIT_L(0); PG8_MMA(0, 0, At, B0); PG8_BAR; PG8_SCHED;
            PG8_LDB(B1, 1, 1); PG8_STAGE(PG8_SB(1, 0), b3, voffB);
            PG8_BAR; PG8_WAIT_L(0); PG8_MMA(0, 1, At, B1); PG8_BAR;
            PG8_LDA(At, 1, 1); PG8_STAGE(PG8_SA(1, 0), a3, voffA);
            PG8_BAR; PG8_WAIT_L(0); PG8_MMA(1, 0, At, B0); PG8_BAR; PG8_SCHED;
            PG8_STAGE(PG8_SB(1, 1), b3 + hstep, voffB);
            PG8_WAIT_V(6); PG8_BAR; PG8_MMA(1, 1, At, B1); PG8_BAR;
            }
        }
        if constexpr (ALIGN_EPI) { if (wr == 0) PG8_BAR; }
        E(acc, cur, wr, wc, fr, fq);
        if (!has_next) break;
#pragma unroll
        for (int a = 0; a < 2; ++a)
#pragma unroll
            for (int b = 0; b < 2; ++b)
#pragma unroll
                for (int m = 0; m < 4; ++m)
#pragma unroll
                    for (int n = 0; n < 2; ++n) acc[a][b][m][n] = (f32x4){0.f, 0.f, 0.f, 0.f};
        cur = nxt; cA = nA; cB = nB; ++ui;
        if constexpr (ALIGN_EPI) { if (wr == 1) PG8_BAR; }
    }
    PG8_WAIT_V(0);
    if constexpr (!ALIGN_EPI) { if (wr == 0) PG8_BAR; }
    PG8_BAR;
#undef PG8_SA
#undef PG8_SB
#undef PG8_STAGE
#undef PG8_LDA
#undef PG8_LDB
#undef PG8_MMA
#undef PG8_WAIT_V
#undef PG8_WAIT_V12
#undef PG8_WAIT_L
#undef PG8_BAR
#undef PG8_SCHED
}
}

#define XB_TMO      128
#define XB_XCNT(j)  (256  + 64 * (j))
#define XB_XSUB(j)  (1280 + 64 * (j))
#define XB_XGEN(j)  (2304 + 64 * (j))
#define XB_TOP      3328
#define XB_TOPGEN   3392
#define XCD_BAR_WORDS 3456
#define XB_SPIN_CAP (1u << 20)
__device__ __forceinline__ unsigned xb_ld(unsigned* p)              { return __hip_atomic_load(p, __ATOMIC_RELAXED, __HIP_MEMORY_SCOPE_AGENT); }
__device__ __forceinline__ unsigned xb_add(unsigned* p, unsigned v) { return __hip_atomic_fetch_add(p, v, __ATOMIC_RELAXED, __HIP_MEMORY_SCOPE_AGENT); }
__device__ __forceinline__ unsigned xb_xcc_id() { return (unsigned)__builtin_amdgcn_s_getreg((3 << 11) | 20) & 0xFu; }
#define XB_SPIN(cond, bar) do { unsigned _sp = 0; while (cond) { __builtin_amdgcn_s_sleep(1); \
    if ((++_sp & 255u) == 0u) { if (xb_ld(&(bar)[XB_TMO])) break; if (_sp > XB_SPIN_CAP) { atomicAdd(&(bar)[XB_TMO], 1u); break; } } } } while (0)
struct XcdBarrier { unsigned* bar; unsigned x; volatile LAS unsigned* st; };
__device__ __forceinline__ XcdBarrier xcd_barrier_post(unsigned* bar, volatile LAS unsigned* st) {
    XcdBarrier b; b.bar = bar; b.x = xb_xcc_id(); b.st = st;
    if (threadIdx.x == 0) st[2] = xb_add(&bar[XB_XCNT(b.x)], 1u);
    return b;
}
__device__ __forceinline__ void xcd_barrier_complete(unsigned* bar, unsigned x, unsigned& nloc, unsigned& nx, unsigned& even8) {
    const unsigned G = gridDim.x * gridDim.y * gridDim.z;
    unsigned sum, cnt, mine, full, sp = 0u;
    for (;;) {
        sum = 0u; cnt = 0u; mine = 0u; full = 0u;
#pragma unroll
        for (unsigned j = 0; j < 16; ++j) { const unsigned c = xb_ld(&bar[XB_XCNT(j)]); sum += c; cnt += (c > 0u) ? 1u : 0u; mine = (j == x) ? c : mine; full += (j < 8u && c == 32u) ? 1u : 0u; }
        even8 = (sum == G && G == 256u && full == 8u) ? 1u : 0u;
        if (sum == G) break;
        __builtin_amdgcn_s_sleep(1);
        if ((++sp & 255u) == 0u) { if (xb_ld(&bar[XB_TMO])) break; if (sp > XB_SPIN_CAP) { atomicAdd(&bar[XB_TMO], 1u); break; } }
    }
    nloc = mine > 0u ? mine : 1u; nx = cnt > 0u ? cnt : 1u;
}
__device__ __forceinline__ void xcd_barrier(const XcdBarrier& b) {
    asm volatile("s_waitcnt vmcnt(0)" ::: "memory");
    __syncthreads();
    if (threadIdx.x == 0) {
        unsigned* bar = b.bar;
        __builtin_amdgcn_s_waitcnt(0);
        unsigned nloc = b.st[0], nx = b.st[1];
        if (nloc == 0u) { unsigned e8; xcd_barrier_complete(bar, b.x, nloc, nx, e8); b.st[0] = nloc; b.st[1] = nx; b.st[3] = e8; }
        const unsigned old = xb_add(&bar[XB_XSUB(b.x)], 1u);
        const unsigned gen = old / nloc;
        if (old + 1u == (gen + 1u) * nloc) {
            __builtin_amdgcn_fence(__ATOMIC_RELEASE, "agent");
            asm volatile("s_waitcnt vmcnt(0)" ::: "memory");
            const unsigned og = xb_add(&bar[XB_TOP], 1u);
            const unsigned tg = og / nx;
            if (og + 1u == (tg + 1u) * nx) xb_add(&bar[XB_TOPGEN], 1u);
            else XB_SPIN(xb_ld(&bar[XB_TOPGEN]) == tg, bar);
            __builtin_amdgcn_fence(__ATOMIC_ACQUIRE, "agent");
            xb_add(&bar[XB_XGEN(b.x)], 1u);
            asm volatile("s_waitcnt vmcnt(0)" ::: "memory");
        } else {
            XB_SPIN(xb_ld(&bar[XB_XGEN(b.x)]) == gen, bar);
            __builtin_amdgcn_fence(__ATOMIC_ACQUIRE, "agent");
            asm volatile("s_waitcnt vmcnt(0)" ::: "memory");
        }
    }
    __syncthreads();
}

template <bool PAIRS = false>
__device__ __forceinline__ void xcd_local_barrier(const XcdBarrier& b, const unsigned p0 = 0u, const unsigned p1 = 0u) {
    asm volatile("s_waitcnt vmcnt(0)" ::: "memory");
    __syncthreads();
    if (threadIdx.x == 0) {
        unsigned* bar = b.bar;
        __builtin_amdgcn_s_waitcnt(0);
        const unsigned nloc = b.st[0];
        const unsigned old = xb_add(&bar[XB_XSUB(b.x)], 1u);
        const unsigned gen = old / nloc;
        if (old + 1u == (gen + 1u) * nloc) xb_add(&bar[XB_XGEN(b.x)], 1u);
        else XB_SPIN(xb_ld(&bar[XB_XGEN(b.x)]) == gen, bar);
        if constexpr (PAIRS) { XB_SPIN(xb_ld(&bar[XB_XGEN(p0)]) <= gen, bar); XB_SPIN(xb_ld(&bar[XB_XGEN(p1)]) <= gen, bar); }
        __builtin_amdgcn_fence(__ATOMIC_ACQUIRE, "agent");
        asm volatile("s_waitcnt vmcnt(0)" ::: "memory");
    }
    __syncthreads();
}

struct Args { const float* in[21]; float* out; unsigned char* ws; int ph_lo, ph_hi; };
struct Frame {
    LAS unsigned char* lds; unsigned char* ldsg;
    int tid, lane, wave, vcu, G;
    int cidx, xq, xl;
    const float* in[21]; unsigned char* ws; unsigned char* outb; float* par;
};
enum { IN_X = 0, IN_C, IN_CTX, IN_CCTX, IN_WMOD, IN_BMOD, IN_NG, IN_WIN, IN_QG, IN_KG, IN_LQ1, IN_LK1, IN_LQ2, IN_LK2, IN_SUBG, IN_LBF, IN_LBB, IN_HG, IN_WBA, IN_WBH, IN_WO };

__device__ __forceinline__ int qk_slot(int l) { return 128 * ((l >> 5) & 1) + 32 * (l >> 6) + 8 * ((l >> 2) & 3) + 4 * ((l >> 4) & 1) + (l & 3); }
template <bool QKPERM>
__device__ __forceinline__ void p0_transpose_item(const float* W, int K, int N, bf16_t* WT, LAS float* scr, int item, int lane, const int opitch) {
    const int nblk = N / 32, kb = item / nblk, nb = item % nblk, k0 = 64 * kb, n0 = 32 * nb;
    float wv[32];
#pragma unroll
    for (int i = 0; i < 32; ++i) wv[i] = W[(size_t)(k0 + 2 * i + (lane >> 5)) * N + n0 + (lane & 31)];
#pragma unroll
    for (int i = 0; i < 32; ++i) scr[(2 * i + (lane >> 5)) * 33 + (lane & 31)] = wv[i];
    LDS_WAIT(); asm volatile("" ::: "memory");
    const int c = lane & 7;
#pragma unroll
    for (int j = 0; j < 4; ++j) { const int n = (lane >> 3) + 8 * j; const LAS float* s = scr + (8 * c) * 33 + n;
        u32x4 o; o.x = pk2(s[0 * 33], s[1 * 33]); o.y = pk2(s[2 * 33], s[3 * 33]); o.z = pk2(s[4 * 33], s[5 * 33]); o.w = pk2(s[6 * 33], s[7 * 33]);
        int nd = n0 + n; if constexpr (QKPERM) { if (nd < 1024 || (nd >= 5120 && nd < 6144)) nd = (nd & ~255) + qk_slot(nd & 255); }
        *(GAS u32x4*)(WT + (size_t)nd * opitch + k0 + 8 * c) = o; }
    LDS_WAIT(); asm volatile("" ::: "memory");
}
__device__ __forceinline__ void p0_weights(Frame& F) {
    {
        LAS float* scr = (LAS float*)(F.lds + F.wave * 16384);
        const int bx = (int)blockIdx.x, nbusy = F.G > 97 ? 97 : 0, gw = (bx >= nbusy ? (bx - nbusy) : (F.G - nbusy) + bx) * 8 + F.wave, NGW = F.G * 8;
        constexpr int I_IN = (D / 64) * (NIN / 32), I_SQ = (D / 64) * (D / 32);
        constexpr int NITEMS = I_IN + 3 * I_SQ;
        for (int it = gw; it < NITEMS; it += NGW) {
            int r = it;
            if (r < I_IN) { p0_transpose_item<true>(F.in[IN_WIN], D, NIN, (bf16_t*)(F.ws + WS_WIN), scr, r, F.lane, D); continue; } r -= I_IN;
            if (r < I_SQ) { p0_transpose_item<false>(F.in[IN_WBA], D, D, (bf16_t*)(F.ws + WS_WBA), scr, r, F.lane, 2 * D); continue; } r -= I_SQ;
            if (r < I_SQ) { p0_transpose_item<false>(F.in[IN_WBH], D, D, (bf16_t*)(F.ws + WS_WBA) + D, scr, r, F.lane, 2 * D); continue; } r -= I_SQ;
            p0_transpose_item<false>(F.in[IN_WO], D, D, (bf16_t*)(F.ws + WS_WO), scr, r, F.lane, D);
        }
    }
}
__device__ __forceinline__ void p0a(Frame& F) {
    const int j = (int)blockIdx.x;
    if (j < 96) {
        LAS float* sc = (LAS float*)F.lds;
        LAS float* red = (LAS float*)(F.lds + 40960);
        { float cv[18];
#pragma unroll
          for (int q = 0; q < 18; ++q) { const int i = F.tid + 512 * q, k = i & 1023; cv[q] = (q < 16) ? F.in[IN_C][(q >> 1) * 1024 + k] : F.in[IN_CCTX][k]; }
#pragma unroll
          for (int q = 0; q < 18; ++q) sc[F.tid + 512 * q] = cv[q] / (1.f + __expf(-cv[q])); }
        __syncthreads();
        const int col = F.tid & 31, ks = F.tid >> 5, n = 32 * j + col;
        float acc[9];
#pragma unroll
        for (int r = 0; r < 9; ++r) acc[r] = 0.f;
        const float* wm = F.in[IN_WMOD];
        for (int kb = 0; kb < 64; kb += 16) {
            float w[16];
#pragma unroll
            for (int u = 0; u < 16; ++u) w[u] = wm[(size_t)(ks * 64 + kb + u) * 3072 + n];
#pragma unroll
            for (int u = 0; u < 16; ++u) { const int k = ks * 64 + kb + u;
#pragma unroll
                for (int r = 0; r < 9; ++r) acc[r] += sc[r * 1024 + k] * w[u]; } }
#pragma unroll
        for (int r = 0; r < 9; ++r) red[(ks * 9 + r) * 32 + col] = acc[r];
        __syncthreads();
        if (F.tid < 288) { const int r = F.tid >> 5, c2 = F.tid & 31; float s = 0.f;
#pragma unroll
            for (int q = 0; q < 16; ++q) s += red[(q * 9 + r) * 32 + c2];
            F.par[PAR_MOD + r * 3072 + 32 * j + c2] = s + F.in[IN_BMOD][32 * j + c2]; }
        __syncthreads();
    } else if (j == 96) {
        for (int i = F.tid; i < 1024; i += 512) {
            { const float p0 = F.in[IN_LBF][i], p1 = F.in[IN_LBF][1024 + i]; F.par[PAR_LBF + i] = 1.f / (1.f + expf(p1 - p0)); }
            { const float p0 = F.in[IN_LBB][i], p1 = F.in[IN_LBB][1024 + i]; F.par[PAR_LBB + i] = 1.f / (1.f + expf(p1 - p0)); }
            { const int pos = i >> 4, fi = i & 15; const double inv = exp(-(double)(2 * fi) / 32.0 * log(10000.0)); const double ang = (double)pos * inv;
              F.par[PAR_ROPE + 2 * i] = (float)cos(ang); F.par[PAR_ROPE + 2 * i + 1] = (float)sin(ang); }
        }
        if (F.tid < 64) {
            const int l = F.tid;
            const float d1 = wave_sum(F.in[IN_LQ1][l] * F.in[IN_LK1][l]), d2 = wave_sum(F.in[IN_LQ2][l] * F.in[IN_LK2][l]);
            float mq = fabsf(F.in[IN_QG][l]), mk = fabsf(F.in[IN_KG][l]);
#pragma unroll
            for (int o = 1; o < 64; o <<= 1) { mq = fmaxf(mq, __shfl_xor(mq, o)); mk = fmaxf(mk, __shfl_xor(mk, o)); }
            if (l == 0) { F.par[PAR_SCAL] = expf(d1) - expf(d2) + LAM_INIT; F.par[PAR_SCAL + 1] = 8.f * mq * mk * LOG2E * 1.01f; }
        }
    }
}
__device__ __forceinline__ void p0b(Frame& F) {
    const int gw = F.vcu * 8 + F.wave, NGW = F.G * 8;
    const GAS f32x4* gn = (const GAS f32x4*)F.in[IN_NG] + F.lane;
    const int nrows = F.xl ? 17 : (M + MC - gw + NGW - 1) / NGW, lw = (F.cidx >> 3) * 8 + F.wave;
#define P0B_ROW(i) (F.xl ? ((lw + 256 * (i)) < T ? F.xq * T + lw + 256 * (i) : M + F.xq * LC + (lw + 256 * (i) - T)) : gw + NGW * (i))
    for (int i0 = 0; i0 < nrows; i0 += 2) {
        const int m0 = P0B_ROW(i0);
        f32x4 v[2][4]; float rstd[2]; const int mm[2] = {m0, (i0 + 1 < nrows) ? P0B_ROW(i0 + 1) : M + MC};
#pragma unroll
        for (int q = 0; q < 2; ++q) { const int m = mm[q] < M + MC ? mm[q] : m0; const float* xrow = (m < M) ? F.in[IN_X] + (size_t)m * D : F.in[IN_CTX] + (size_t)(m - M) * D;
            const GAS f32x4* xr = (const GAS f32x4*)xrow + F.lane;
#pragma unroll
            for (int j = 0; j < 4; ++j) v[q][j] = xr[64 * j]; }
#pragma unroll
        for (int q = 0; q < 2; ++q) { float s = 0.f;
#pragma unroll
            for (int j = 0; j < 4; ++j) s += (v[q][j].x * v[q][j].x + v[q][j].y * v[q][j].y) + (v[q][j].z * v[q][j].z + v[q][j].w * v[q][j].w);
            rstd[q] = __builtin_amdgcn_rsqf(wave_sum(s) * (1.f / D) + EPS); }
#pragma unroll
        for (int q = 0; q < 2; ++q) { const int m = mm[q]; if (m >= M + MC) break;
            const bool lat = m < M; const int mr = lat ? (m >> 12) : 8;
            bf16_t* orow = lat ? (bf16_t*)(F.outb + OUT_H) + (size_t)m * D : (bf16_t*)(F.ws + WS_HC) + (size_t)(m - M) * D;
            const GAS f32x4* sh = (const GAS f32x4*)(F.par + PAR_MOD + mr * 3072) + F.lane;
            const GAS f32x4* scl = (const GAS f32x4*)(F.par + PAR_MOD + mr * 3072 + 1024) + F.lane;
            GAS u32x2* o8 = (GAS u32x2*)orow + F.lane;
#pragma unroll
            for (int j = 0; j < 4; ++j) { const f32x4 g = gn[64 * j], a = scl[64 * j], b = sh[64 * j];
                const f32x4 h = v[q][j] * rstd[q] * g * (a + 1.f) + b;
                u32x2 w; w.x = pk2(h.x, h.y); w.y = pk2(h.z, h.w); o8[64 * j] = w; } }
    }
#undef P0B_ROW
}

struct SchedIn {
    int G, c; const char* H; const char* HC; const char* W;
    __device__ __forceinline__ bool next(int i, pg8::Unit& u) const {
        const int L = i * G + c; constexpr int NLAT = 128 * 28, NCTX = 8 * 20;
        if (L >= NLAT + NCTX) return false;
        if (L < NLAT) { pg8::tile_map(L, 128, 28, u.pm, u.pn); u.kind = 0; u.A = H + (size_t)u.pm * (256 * 1024 * 2); }
        else { const int r = L - NLAT; u.pm = r & 7; u.pn = r >> 3; u.kind = 1; u.A = HC + (size_t)u.pm * (256 * 1024 * 2); }
        u.B = W + (size_t)u.pn * (256 * 1024 * 2); return true;
    }
};
template <int MODE> struct EpiProbe {
    static constexpr bool PERM = true, MID = false, STORES16 = false;
    unsigned char* scratch;
    __device__ __forceinline__ void operator()(const f32x4 (&acc)[2][2][4][2], const pg8::Unit& u, int wr, int wc, int fr, int fq) const {
        if constexpr (MODE == 3) {
#pragma unroll
            for (int ai = 0; ai < 2; ++ai)
#pragma unroll
                for (int bj = 0; bj < 2; ++bj)
#pragma unroll
                    for (int m = 0; m < 4; ++m) asm volatile("" :: "v"(acc[ai][bj][m][0]), "v"(acc[ai][bj][m][1]));
            return; }
        bf16_t* base = (bf16_t*)scratch; const int row0 = (u.pm & 127) * 256 + wr * 64 + fr, cg0 = (u.pn & 3) * 256 + wc * 32 + 8 * fq;
#pragma unroll
        for (int ai = 0; ai < 2; ++ai)
#pragma unroll
            for (int m = 0; m < 4; ++m) { bf16_t* rowp = base + (size_t)(row0 + ai * 128 + m * 16) * 1024 + cg0;
#pragma unroll
                for (int bj = 0; bj < 2; ++bj) { const f32x4 v0 = acc[ai][bj][m][0], v1 = acc[ai][bj][m][1]; u32x4 w;
                    w.x = cvt_pk_bf16(v0[0], v0[1]); w.y = cvt_pk_bf16(v0[2], v0[3]); w.z = cvt_pk_bf16(v1[0], v1[1]); w.w = cvt_pk_bf16(v1[2], v1[3]);
                    *(u32x4*)(rowp + bj * 128) = w; } }
    }
};
struct EpiIn {
    static constexpr bool PERM = true, MID = false, STORES16 = true;
    unsigned char* ws; const float* par; const float* kgain; const float* qgain;
    __device__ __forceinline__ void qk_epi(const f32x4 (&acc)[2][2][4][2], const pg8::Unit& u, int wr, int wc, int fr, int fq, const bool isq) const {
        const int head = (u.pn & 3) * 2 + (wc >> 1), map = wc & 1;
        const float gs = isq ? 0.125f * LOG2E : 1.f; const float* gp = (isq ? qgain : kgain) + 4 * fq;
        const bool rope = (u.kind == 0);
        unsigned char* ub; int rs;
        if (isq) { ub = ws + WS_Q + ((size_t)(u.pm * 256 + wr * 64) * 1024 + head * 128 + map * 64) * 2; rs = 1024; }
        else { const int bb = rope ? (u.pm >> 4) : u.pm, s0 = rope ? LC + (u.pm & 15) * 256 : 0; ub = ws + WS_KALL + (((size_t)(bb * NH + head) * S + s0 + wr * 64) * 128 + map * 64) * 2; rs = 128; }
        const unsigned loff = (unsigned)(fr * rs + 4 * fq) * 2u;
#pragma unroll
        for (int ai = 0; ai < 2; ++ai)
#pragma unroll
            for (int m = 0; m < 4; ++m) {
                const int lr = ai * 128 + wr * 64 + m * 16 + fr;
                float ss = 0.f;
#pragma unroll
                for (int bj = 0; bj < 2; ++bj)
#pragma unroll
                    for (int n = 0; n < 2; ++n) { const f32x4 x = acc[ai][bj][m][n]; ss += (x[0] * x[0] + x[1] * x[1]) + (x[2] * x[2] + x[3] * x[3]); }
                ss += __shfl_xor(ss, 16); ss += __shfl_xor(ss, 32);
                const float rstd = gs * __builtin_amdgcn_rsqf(ss * (1.f / 64.f) + EPS);
                const int tpos = (u.pm & 15) * 256 + lr;
                unsigned char* rowp = ub + (size_t)((ai * 128 + m * 16) * rs * 2) + loff;
#pragma unroll
                for (int bj = 0; bj < 2; ++bj) {
                    f32x4 a = acc[ai][bj][m][0] * rstd * *(const f32x4*)(gp + 32 * bj), bq = acc[ai][bj][m][1] * rstd * *(const f32x4*)(gp + 32 * bj + 16);
                    if (rope) { const int pos = bj ? (tpos & 63) : (tpos >> 6);
                        const f32x4 c0 = *(const f32x4*)(par + PAR_ROPE + pos * 32 + 8 * fq), c1 = *(const f32x4*)(par + PAR_ROPE + pos * 32 + 8 * fq + 4);
                        const f32x4 cs = (f32x4){c0[0], c0[2], c1[0], c1[2]}, sn = (f32x4){c0[1], c0[3], c1[1], c1[3]};
                        const f32x4 a2 = a * cs - bq * sn; bq = bq * cs + a * sn; a = a2; }
                    u32x2 w0, w1; w0.x = cvt_pk_bf16(a[0], a[1]); w0.y = cvt_pk_bf16(a[2], a[3]); w1.x = cvt_pk_bf16(bq[0], bq[1]); w1.y = cvt_pk_bf16(bq[2], bq[3]);
                    *(u32x2*)(rowp + 64 * bj) = w0; *(u32x2*)(rowp + 64 * bj + 32) = w1; }
            }
    }
    __device__ __forceinline__ void operator()(const f32x4 (&acc)[2][2][4][2], const pg8::Unit& u, int wr, int wc, int fr, int fq) const {
        const int grp = u.pn >> 2, cg0 = (u.pn & 3) * 256 + wc * 32 + 8 * fq;
        if (grp == 0 || grp == 5) { qk_epi(acc, u, wr, wc, fr, fq, grp == 5); return; }
        unsigned char* ub; size_t hstride;
        { const int hd0 = (u.pn & 3) * 2;
          if (grp < 5) { const int bb = (u.kind == 0) ? (u.pm >> 4) : u.pm, s0 = (u.kind == 0) ? LC + (u.pm & 15) * 256 : 0;
              ub = ws + WS_KALL + (size_t)grp * (68 * MiB) + (((size_t)(bb * NH + hd0) * S + s0 + wr * 64) * 128 + wc * 32) * 2; hstride = (size_t)S * 256; }
          else { ub = ws + WS_QH + (((size_t)((u.pm >> 4) * NH + hd0) * T + (u.pm & 15) * 256 + wr * 64) * 128 + wc * 32) * 2; hstride = (size_t)T * 256; } }
        const unsigned loff = (unsigned)(fr * 128 + 8 * fq) * 2u;
        f32x4 lb[2][2];
        if (grp == 3 || grp == 4) {
            const float* lbp = par + (grp == 3 ? PAR_LBF : PAR_LBB) + cg0;
#pragma unroll
            for (int bj = 0; bj < 2; ++bj)
#pragma unroll
                for (int n = 0; n < 2; ++n) lb[bj][n] = *(const f32x4*)(lbp + bj * 128 + 4 * n);
        }
#pragma unroll
        for (int ai = 0; ai < 2; ++ai)
#pragma unroll
            for (int m = 0; m < 4; ++m) { unsigned char* rowp = ub + (size_t)((ai * 128 + m * 16) * 256) + loff;
#pragma unroll
                for (int bj = 0; bj < 2; ++bj) { f32x4 v0 = acc[ai][bj][m][0], v1 = acc[ai][bj][m][1]; u32x4 w;
                    if (grp == 3 || grp == 4) {
#pragma unroll
                        for (int e = 0; e < 4; ++e) { v0[e] = __logf(lb[bj][0][e] + (1.f - lb[bj][0][e]) * sigmoidf_(v0[e])); v1[e] = __logf(lb[bj][1][e] + (1.f - lb[bj][1][e]) * sigmoidf_(v1[e])); }
                        w.x = pk_f16(v0[0], v0[1]); w.y = pk_f16(v0[2], v0[3]); w.z = pk_f16(v1[0], v1[1]); w.w = pk_f16(v1[2], v1[3]);
                    } else {
                        if (grp == 6) {
#pragma unroll
                            for (int e = 0; e < 4; ++e) { v0[e] = siluf_(v0[e]); v1[e] = siluf_(v1[e]); }
                        }
                        w.x = cvt_pk_bf16(v0[0], v0[1]); w.y = cvt_pk_bf16(v0[2], v0[3]); w.z = cvt_pk_bf16(v1[0], v1[1]); w.w = cvt_pk_bf16(v1[2], v1[3]);
                    }
                    *(u32x4*)(rowp + bj * hstride) = w; } }
    }
};

namespace attn {
constexpr int LDK = 128, KVBLK = 64;
constexpr int SHM_V = KVBLK * 128 * 2, SHM_K = KVBLK * 128 * 2;
#define KSWZ(row, colB) ((row) * 256 + ((colB) ^ (((row) & 15) << 4)))
#define SBAR() __builtin_amdgcn_sched_barrier(0)
__device__ __forceinline__ int crow(int r, int hi) { return (r & 3) + 8 * (r >> 2) + 4 * hi; }
__device__ __forceinline__ void expA_(f32x16& p0) {
#pragma unroll
    for (int r = 0; r < 16; ++r) p0[r] = __builtin_amdgcn_exp2f(p0[r]);
}
template <bool NOEXP>
__device__ __forceinline__ void finishSM_(f32x16& p0, f32x16& p1, float& l_reg, bf16x8& pa0, bf16x8& pa1, bf16x8& pa2, bf16x8& pa3) {
    if constexpr (!NOEXP) {
#pragma unroll
    for (int r = 0; r < 16; ++r) p1[r] = __builtin_amdgcn_exp2f(p1[r]); }
    float ps = 0;
#pragma unroll
    for (int r = 0; r < 16; ++r) ps += p0[r];
#pragma unroll
    for (int r = 0; r < 16; ++r) ps += p1[r];
    l_reg += ps;
#define PK4(P, BASE, OUT) do { unsigned a0 = cvt_pk_bf16(P[BASE + 0], P[BASE + 1]), a1 = cvt_pk_bf16(P[BASE + 2], P[BASE + 3]);   \
    unsigned b0 = cvt_pk_bf16(P[BASE + 4], P[BASE + 5]), b1 = cvt_pk_bf16(P[BASE + 6], P[BASE + 7]);                              \
    auto r0 = __builtin_amdgcn_permlane32_swap(a0, b0, false, false); auto r1 = __builtin_amdgcn_permlane32_swap(a1, b1, false, false); \
    u32x4 w = {r0[0], r1[0], r0[1], r1[1]}; OUT = *reinterpret_cast<bf16x8*>(&w); } while (0)
    PK4(p0, 0, pa0); PK4(p0, 8, pa1); PK4(p1, 0, pa2); PK4(p1, 8, pa3);
#undef PK4
}
__device__ __forceinline__ void qkt_(f32x16& p0, f32x16& p1, const char* Ks, const bf16x8* qr, int r32, int hi, int mapcol) {
    p0 = f32x16{}; p1 = f32x16{};
#pragma unroll
    for (int d0 = 0; d0 < 4; ++d0) { const int cb = mapcol + (d0 * 16 + hi * 8) * 2;
        const bf16x8 b0 = *reinterpret_cast<const bf16x8*>(Ks + KSWZ(r32, cb));
        const bf16x8 b1 = *reinterpret_cast<const bf16x8*>(Ks + KSWZ(32 + r32, cb));
        p0 = __builtin_amdgcn_mfma_f32_32x32x16_bf16(b0, qr[d0], p0, 0, 0, 0); p1 = __builtin_amdgcn_mfma_f32_32x32x16_bf16(b1, qr[d0], p1, 0, 0, 0); }
}
__device__ __forceinline__ int v_st(int k, int c) { const int kk = (k & ~0xC) | ((k & 4) << 1) | ((k & 8) >> 1); return ((kk >> 3) * 4 + (c >> 5)) * 512 + ((kk & 7) * 32 + (c & 31)) * 2; }
__device__ __forceinline__ int v_rd_base(int lane) { return ((lane & 3) << 3) | (((lane >> 2) & 3) << 6) | (((lane >> 4) & 1) << 5) | (((lane >> 5) & 1) << 8); }
constexpr int v_rd_off(int d0, int ks, int half) { return d0 * 512 + ks * 4096 + half * 2048; }
typedef short v4i16_t __attribute__((ext_vector_type(4)));
template <int OFF> __device__ __forceinline__ s16x4 tr_read(int vb) {
    return __builtin_bit_cast(s16x4, __builtin_amdgcn_ds_read_tr16_b64_v4i16((LAS v4i16_t*)(unsigned)(vb + OFF)));
}
struct VFrag { s16x4 l0, h0, l1, h1, l2, h2, l3, h3; };
template <int D0> __device__ __forceinline__ void v_reads(VFrag& f, int vb) {
    f.l0 = tr_read<v_rd_off(D0, 0, 0)>(vb); f.h0 = tr_read<v_rd_off(D0, 0, 1)>(vb); f.l1 = tr_read<v_rd_off(D0, 1, 0)>(vb); f.h1 = tr_read<v_rd_off(D0, 1, 1)>(vb);
    f.l2 = tr_read<v_rd_off(D0, 2, 0)>(vb); f.h2 = tr_read<v_rd_off(D0, 2, 1)>(vb); f.l3 = tr_read<v_rd_off(D0, 3, 0)>(vb); f.h3 = tr_read<v_rd_off(D0, 3, 1)>(vb);
}
__device__ __forceinline__ void pv_mma(f32x16& od, const VFrag& f, bf16x8 pa0, bf16x8 pa1, bf16x8 pa2, bf16x8 pa3) {
#define PK(L, H) (bf16x8){L[0], L[1], L[2], L[3], H[0], H[1], H[2], H[3]}
    od = __builtin_amdgcn_mfma_f32_32x32x16_bf16(pa0, PK(f.l0, f.h0), od, 0, 0, 0);
    od = __builtin_amdgcn_mfma_f32_32x32x16_bf16(pa1, PK(f.l1, f.h1), od, 0, 0, 0);
    od = __builtin_amdgcn_mfma_f32_32x32x16_bf16(pa2, PK(f.l2, f.h2), od, 0, 0, 0);
    od = __builtin_amdgcn_mfma_f32_32x32x16_bf16(pa3, PK(f.l3, f.h3), od, 0, 0, 0);
#undef PK
}
__device__ __forceinline__ void pv_d0_(f32x16* o, int vb, bf16x8 pa0, bf16x8 pa1, bf16x8 pa2, bf16x8 pa3) {
    VFrag fa, fb;
    v_reads<0>(fa, vb); v_reads<1>(fb, vb);
    __builtin_amdgcn_sched_group_barrier(0x100, 16, 0);
    pv_mma(o[0], fa, pa0, pa1, pa2, pa3);
    v_reads<2>(fa, vb); pv_mma(o[1], fb, pa0, pa1, pa2, pa3);
    v_reads<3>(fb, vb); pv_mma(o[2], fa, pa0, pa1, pa2, pa3);
    pv_mma(o[3], fb, pa0, pa1, pa2, pa3);
}
__device__ __forceinline__ void glds16s(const void* gbase, unsigned voff, unsigned lds_dst) { unsigned keep;
    asm volatile("s_mov_b32 %0, m0\n\ts_mov_b32 m0, %3\n\ts_nop 0\n\tglobal_load_lds_dwordx4 %1, %2\n\ts_mov_b32 m0, %0" : "=&s"(keep) : "v"(voff), "s"(gbase), "s"(lds_dst) : "memory"); }
__device__ __forceinline__ void glds16(const void* gsrc, unsigned lds_dst) { unsigned keep;
    asm volatile("s_mov_b32 %0, m0\n\ts_mov_b32 m0, %2\n\ts_nop 0\n\tglobal_load_lds_dwordx4 %1, off\n\ts_mov_b32 m0, %0" : "=&s"(keep) : "v"(gsrc), "s"(lds_dst) : "memory"); }
template <int ABL>
__device__ __forceinline__ void attn_unit(const bf16_t* Qb, bf16_t* Ob, const bf16_t* __restrict__ Kh, const bf16_t* __restrict__ Vh, const float lam, const float shift2, const float* __restrict__ subg, char* lds, LAS unsigned char* ldsl) {
#define qkt(P0, P1, ...) do { if constexpr (ABL & 4) { P0 = f32x16{}; P1 = f32x16{}; asm volatile("" : "+v"(P0), "+v"(P1)); } else { attn::qkt_(P0, P1, __VA_ARGS__); } } while (0)
#define expA(P0) do { if constexpr (!(ABL & 2)) attn::expA_(P0); } while (0)
#define finishSM(...) attn::finishSM_<(ABL & 2) != 0>(__VA_ARGS__)
#define pv_d0(o, vb, a0, a1, a2, a3) do { if constexpr (ABL & 1) { asm volatile("" :: "v"(a0), "v"(a1), "v"(a2), "v"(a3)); } else { attn::pv_d0_(o, vb, a0, a1, a2, a3); } } while (0)
    int tid_ = threadIdx.x; asm volatile("" : "+v"(tid_));
    const int tid = tid_, wid = __builtin_amdgcn_readfirstlane(tid >> 6), lane = tid & 63, r32 = lane & 31, hi = lane >> 5, map = wid >> 2, wq = wid & 3;
    float l_reg = 0; f32x16 o[4] = {}; bf16x8 qr[4];
    const bf16_t* Qw = Qb + (size_t)(wq * 32 + r32) * 1024 + map * 64 + hi * 8;
#pragma unroll
    for (int d0 = 0; d0 < 4; ++d0) qr[d0] = *reinterpret_cast<const bf16x8*>(Qw + d0 * 16);
    const int mapcol = map * 128;
    const int vb0 = (int)(uintptr_t)lds + v_rd_base(lane);
    constexpr int SLOT = SHM_V + SHM_K;
    unsigned ksrc[2], vsrc[2];
#pragma unroll
    for (int i = 0; i < 2; ++i) {
        { const int row = 8 * wid + 4 * i + (lane >> 4), c = (lane & 15) ^ (row & 15); ksrc[i] = (unsigned)(row * 256 + c * 16); }
        { const int sub = 4 * wid + 2 * i + (lane >> 5), kk = (sub >> 2) * 8 + ((lane >> 2) & 7), key = (kk & ~0xC) | ((kk & 4) << 1) | ((kk & 8) >> 1), c = (sub & 3) * 32 + (lane & 3) * 8;
          vsrc[i] = (unsigned)(key * 256 + c * 2); }
    }
    const unsigned ldsw = (unsigned)wid * 2048u, lds0 = (unsigned)(uintptr_t)lds;
#define DMA(t) do { if constexpr (ABL & 8) break; const char* vt_ = (const char*)Vh + (size_t)(t) * (KVBLK * LDK * 2); const char* kt_ = (const char*)Kh + (size_t)(t) * (KVBLK * LDK * 2); const unsigned so_ = (unsigned)((t) & 3) * SLOT + ldsw; \
    _Pragma("unroll") for (int i_ = 0; i_ < 2; ++i_) { \
        glds16s(vt_, vsrc[i_], (unsigned)__builtin_amdgcn_readfirstlane((int)(lds0 + so_ + i_ * 1024))); \
        glds16s(kt_, ksrc[i_], (unsigned)__builtin_amdgcn_readfirstlane((int)(lds0 + so_ + SHM_V + i_ * 1024))); } } while (0)
#define WAITBAR(N) asm volatile("s_waitcnt vmcnt(" #N ") lgkmcnt(0)\n\ts_barrier" ::: "memory")
    f32x16 pA0, pA1, pB0, pB1; bf16x8 pa0, pa1, pa2, pa3; constexpr int NT = S / KVBLK;
#define SL(t) (((t) & 3) * SLOT)
    DMA(0); DMA(1); WAITBAR(4);
    if (map == 0) {
        DMA(2); qkt(pA0, pA1, lds + SHM_V, qr, r32, hi, mapcol); expA(pA0);
#pragma unroll 1
        for (int j = 1; j + 1 < NT; j += 2) {
            WAITBAR(4); if (j + 2 < NT) DMA(j + 2);
            qkt(pB0, pB1, lds + SL(j) + SHM_V, qr, r32, hi, mapcol);
            finishSM(pA0, pA1, l_reg, pa0, pa1, pa2, pa3);
            pv_d0(o, vb0 + SL(j - 1), pa0, pa1, pa2, pa3); expA(pB0);
            if (j + 3 < NT) { WAITBAR(4); DMA(j + 3); } else { WAITBAR(0); }
            qkt(pA0, pA1, lds + SL(j + 1) + SHM_V, qr, r32, hi, mapcol);
            finishSM(pB0, pB1, l_reg, pa0, pa1, pa2, pa3);
            pv_d0(o, vb0 + SL(j), pa0, pa1, pa2, pa3); expA(pA0);
        }
        WAITBAR(0);
        qkt(pB0, pB1, lds + SL(NT - 1) + SHM_V, qr, r32, hi, mapcol);
        finishSM(pA0, pA1, l_reg, pa0, pa1, pa2, pa3);
        pv_d0(o, vb0 + SL(NT - 2), pa0, pa1, pa2, pa3); expA(pB0);
        finishSM(pB0, pB1, l_reg, pa0, pa1, pa2, pa3);
        pv_d0(o, vb0 + SL(NT - 1), pa0, pa1, pa2, pa3);
    } else {
        DMA(2); qkt(pA0, pA1, lds + SHM_V, qr, r32, hi, mapcol); expA(pA0); finishSM(pA0, pA1, l_reg, pa0, pa1, pa2, pa3);
#pragma unroll 1
        for (int j = 1; j < NT; ++j) {
            if (j + 2 < NT) { WAITBAR(4); DMA(j + 2); } else { WAITBAR(0); }
            pv_d0(o, vb0 + SL(j - 1), pa0, pa1, pa2, pa3);
            qkt(pA0, pA1, lds + SL(j) + SHM_V, qr, r32, hi, mapcol); expA(pA0);
            finishSM(pA0, pA1, l_reg, pa0, pa1, pa2, pa3);
        }
        pv_d0(o, vb0 + SL(NT - 1), pa0, pa1, pa2, pa3);
    }
#undef SL
#undef DMA
#undef WAITBAR
    { auto rr = __builtin_amdgcn_permlane32_swap(__float_as_uint(l_reg), __float_as_uint(l_reg), false, false); l_reg = __uint_as_float(rr[0]) + __uint_as_float(rr[1]); }
    const int lane_e = (int)__builtin_amdgcn_mbcnt_hi(~0u, __builtin_amdgcn_mbcnt_lo(~0u, 0u)), r32e = lane_e & 31, hie = lane_e >> 5;
    float sg[4];
#pragma unroll
    for (int d0 = 0; d0 < 4; ++d0) sg[d0] = subg[32 * d0 + r32e] * (1.f - LAM_INIT);
    float* wsf = (float*)(lds + XS_OFF) + wid * 64;
    if (hie == 0) wsf[r32e] = l_reg;
    asm volatile("s_waitcnt lgkmcnt(0)" ::: "memory");
    float rli[16];
#pragma unroll
    for (int r = 0; r < 16; ++r) rli[r] = __builtin_amdgcn_rcpf(wsf[crow(r, hie)]);
    __syncthreads();
    float* exch = (float*)lds + (size_t)wq * 4096 + lane_e;
#define EXPORT_ROWS(R0, SCALE) do { _Pragma("unroll") for (int r = (R0); r < (R0) + 8; ++r) { const float sc2 = (SCALE) * rli[r]; \
        _Pragma("unroll") for (int d0 = 0; d0 < 4; ++d0) exch[(r * 4 + d0) * 64] = o[d0][r] * sc2; } } while (0)
    if (map == 0) EXPORT_ROWS(8, 1.f); else EXPORT_ROWS(0, lam);
#undef EXPORT_ROWS
    __syncthreads();
    {
#define FINISH_ROWS(R0, OWN, SGN) do { _Pragma("unroll") for (int r = (R0); r < (R0) + 8; ++r) { \
            float v[4]; float ss = 0.f; const float own = (OWN) * rli[r]; \
            _Pragma("unroll") for (int d0 = 0; d0 < 4; ++d0) { v[d0] = (SGN) * (o[d0][r] * own - exch[(r * 4 + d0) * 64]); ss += v[d0] * v[d0]; } \
            ss += __shfl_xor(ss, 1); ss += __shfl_xor(ss, 2); ss += __shfl_xor(ss, 4); ss += __shfl_xor(ss, 8); ss += __shfl_xor(ss, 16); \
            const float rstd = __builtin_amdgcn_rsqf(ss * (1.f / 128.f) + EPS); \
            bf16_t* srow = (bf16_t*)(lds + 65536 + wq * 8704 + crow(r, hie) * 272) + r32e; \
            _Pragma("unroll") for (int d0 = 0; d0 < 4; ++d0) srow[32 * d0] = (bf16_t)f2bf(v[d0] * rstd * sg[d0]); } } while (0)
        if (map == 0) FINISH_ROWS(0, 1.f, 1.f); else FINISH_ROWS(8, lam, -1.f);
#undef FINISH_ROWS
        asm volatile("s_waitcnt lgkmcnt(0)" ::: "memory");
#pragma unroll
        for (int i = 0; i < 4; ++i) { const int row = 16 * map + 4 * i + (lane_e >> 4), ch = lane_e & 15;
            const u32x4 val = *(const u32x4*)(lds + 65536 + wq * 8704 + row * 272 + ch * 16);
            *(u32x4*)(Ob + (size_t)(wq * 32 + row) * 1024 + ch * 8) = val; }
    }
    __syncthreads();
#undef qkt
#undef expA
#undef finishSM
#undef pv_d0
}
#undef KSWZ
#undef SBAR
}

namespace hg {
typedef short v4i16_t __attribute__((ext_vector_type(4)));
constexpr int PITCH = 288, APITCH = 160;
constexpr int OFF_QT = 0, OFF_KT = 64 * PITCH, OFF_VV = 2 * 64 * PITCH, OFF_ASC = 3 * 64 * PITCH, OFF_OB = OFF_ASC + 64 * APITCH, OFF_TOT = OFF_OB + 64 * PITCH, OFF_C1 = OFF_TOT + 4096, OFF_C2 = OFF_C1 + 512, OFF_D = OFF_C2 + 512, OFF_VV2 = OFF_D + 512, OFF_QST = OFF_VV2 + 64 * PITCH, OFF_END = OFF_QST + 512 * 32;
static_assert(OFF_END <= RING_BYTES, "hgrn LDS");
__device__ __forceinline__ bf16x8 trpair(const LAS unsigned char* p) {
    const s16x4 lo = __builtin_bit_cast(s16x4, __builtin_amdgcn_ds_read_tr16_b64_v4i16((LAS v4i16_t*)p));
    const s16x4 hi = __builtin_bit_cast(s16x4, __builtin_amdgcn_ds_read_tr16_b64_v4i16((LAS v4i16_t*)(p + 8 * PITCH)));
    return (bf16x8){lo[0], lo[1], lo[2], lo[3], hi[0], hi[1], hi[2], hi[3]};
}
__device__ __forceinline__ int prow(int t) { return (t & ~12) | ((t & 4) << 1) | ((t & 8) >> 1); }
constexpr int QPITCH = 272;
struct HgRegs { u32x4 ga, gb, qa, qb, va, vb; };
struct HgG { u32x4 ga, gb; };
#define HG_ROW(p) ((dir == 0) ? (p) : ((p) < LC ? (LC - 1 - (p)) : (S + LC - 1 - (p))))
template <int ABL>
__device__ __forceinline__ void hg_prefetch(HgRegs& R, const int c, const int dir, const int t0, const int oc, const unsigned short* G, const unsigned short* I, const unsigned short* QH) {
    if constexpr (ABL & 4) return;
    const int r0 = HG_ROW(c * 64 + t0), r1 = HG_ROW(c * 64 + t0 + 1);
    R.ga = __builtin_nontemporal_load((const u32x4*)(G + (size_t)r0 * 128 + 8 * oc)); R.gb = __builtin_nontemporal_load((const u32x4*)(G + (size_t)r1 * 128 + 8 * oc));
    R.va = __builtin_nontemporal_load((const u32x4*)(I + (size_t)r0 * 128 + 8 * oc)); R.vb = __builtin_nontemporal_load((const u32x4*)(I + (size_t)r1 * 128 + 8 * oc));
    { const int q0 = c >= LC / 64 ? r0 - LC : 0, q1 = c >= LC / 64 ? r1 - LC : 0;
      R.qa = __builtin_nontemporal_load((const u32x4*)(QH + (size_t)q0 * 128 + 8 * oc)); R.qb = __builtin_nontemporal_load((const u32x4*)(QH + (size_t)q1 * 128 + 8 * oc)); }
}
#define HG_BAR() asm volatile("s_waitcnt lgkmcnt(0)\n\ts_barrier" ::: "memory")
__device__ __forceinline__ void hg_prefix(const HgG& R, float (&inc)[8], float (&ex)[8], const int lg) {
#pragma unroll
    for (int ep = 0; ep < 4; ++ep) {
#pragma unroll
        for (int hh = 0; hh < 2; ++hh) { const int e = 2 * ep + hh;
            const float s = (hh ? f16hi(R.ga[ep]) : f16lo(R.ga[ep])) + (hh ? f16hi(R.gb[ep]) : f16lo(R.gb[ep]));
            const float p1 = __builtin_bit_cast(float, __builtin_amdgcn_mov_dpp(__builtin_bit_cast(int, s), 0x90, 0xf, 0xf, false));
            const float s2 = (lg >= 1) ? s + p1 : s;
            const float p2 = __builtin_bit_cast(float, __builtin_amdgcn_mov_dpp(__builtin_bit_cast(int, s2), 0x44, 0xf, 0xf, false));
            inc[e] = (lg >= 2) ? s2 + p2 : s2; ex[e] = inc[e] - s; } }
}
__device__ __forceinline__ void hg_e1(const HgG& R, float (&ex)[8], LAS unsigned char* lds, const int w, const int oc, const int lg) {
    float inc[8]; hg_prefix(R, inc, ex, lg);
    if (lg == 3) { *(LAS f32x4*)(lds + OFF_TOT + (w * 128 + 8 * oc) * 4) = (f32x4){inc[0], inc[1], inc[2], inc[3]}; *(LAS f32x4*)(lds + OFF_TOT + (w * 128 + 8 * oc + 4) * 4) = (f32x4){inc[4], inc[5], inc[6], inc[7]}; }
}
__device__ __forceinline__ void hg_e2(const HgG& R, const float (&ex)[8], LAS unsigned char* lds, const int tid, const int w, const int oc, const int lg, const int t0) {
    float my_off0 = 0.f, my_off1 = 0.f, my_bm0 = 0.f, my_bm1 = 0.f;
    { float cum0 = 0.f, cum1 = 0.f;
#pragma unroll
      for (int k = 0; k < 8; ++k) { const f32x2 t = *(const LAS f32x2*)(lds + OFF_TOT + (k * 128 + 8 * oc + 2 * lg) * 4);
          if (k == w) { my_off0 = cum0; my_off1 = cum1; } cum0 += t.x; cum1 += t.y; if (k == 3) { my_bm0 = cum0; my_bm1 = cum1; } }
      if (w == 0) {
          *(LAS f32x2*)(lds + OFF_C1 + (8 * oc + 2 * lg) * 4) = (f32x2){__builtin_amdgcn_exp2f(my_bm0 * LOG2E), __builtin_amdgcn_exp2f(my_bm1 * LOG2E)};
          *(LAS f32x2*)(lds + OFF_C2 + (8 * oc + 2 * lg) * 4) = (f32x2){__builtin_amdgcn_exp2f((cum0 - my_bm0) * LOG2E), __builtin_amdgcn_exp2f((cum1 - my_bm1) * LOG2E)};
          *(LAS f32x2*)(lds + OFF_D + (8 * oc + 2 * lg) * 4) = (f32x2){__builtin_amdgcn_exp2f(cum0 * LOG2E), __builtin_amdgcn_exp2f(cum1 * LOG2E)}; } }
#define HG_QB(v, ep) __builtin_bit_cast(float, __builtin_amdgcn_mov_dpp(__builtin_bit_cast(int, v), (ep) * 0x55, 0xf, 0xf, false))
    const u32x4 qa = *(const LAS u32x4*)(lds + OFF_QST + tid * 32), qb = *(const LAS u32x4*)(lds + OFF_QST + tid * 32 + 16);
    u32x4 oq0, oq1, ok0, ok1;
#define HG_E2_EP(ep) do { \
        const float off0 = HG_QB(my_off0, ep), off1 = HG_QB(my_off1, ep), bm0 = HG_QB(my_bm0, ep), bm1 = HG_QB(my_bm1, ep); \
        const float xa0 = f16lo(R.ga[ep]), xa1 = f16hi(R.ga[ep]), xb0 = f16lo(R.gb[ep]), xb1 = f16hi(R.gb[ep]); \
        const float ba0 = off0 + ex[2 * ep] + xa0, ba1 = off1 + ex[2 * ep + 1] + xa1, bb0 = ba0 + xb0, bb1 = ba1 + xb1; \
        const float eaa0 = __builtin_amdgcn_exp2f(fminf(ba0 - bm0, 80.f) * LOG2E), eaa1 = __builtin_amdgcn_exp2f(fminf(ba1 - bm1, 80.f) * LOG2E); \
        const float eab0 = __builtin_amdgcn_exp2f(fminf(bb0 - bm0, 80.f) * LOG2E), eab1 = __builtin_amdgcn_exp2f(fminf(bb1 - bm1, 80.f) * LOG2E); \
        const float eba0 = __builtin_amdgcn_exp2f(fminf(bm0 - ba0, 80.f) * LOG2E), eba1 = __builtin_amdgcn_exp2f(fminf(bm1 - ba1, 80.f) * LOG2E); \
        const float ebb0 = __builtin_amdgcn_exp2f(fminf(bm0 - bb0, 80.f) * LOG2E), ebb1 = __builtin_amdgcn_exp2f(fminf(bm1 - bb1, 80.f) * LOG2E); \
        const float ka0 = 1.f - __builtin_amdgcn_exp2f(xa0 * LOG2E), ka1 = 1.f - __builtin_amdgcn_exp2f(xa1 * LOG2E), kb0 = 1.f - __builtin_amdgcn_exp2f(xb0 * LOG2E), kb1 = 1.f - __builtin_amdgcn_exp2f(xb1 * LOG2E); \
        oq0[ep] = cvt_pk_bf16(bflo(qa[ep]) * eaa0, bfhi(qa[ep]) * eaa1); oq1[ep] = cvt_pk_bf16(bflo(qb[ep]) * eab0, bfhi(qb[ep]) * eab1); \
        ok0[ep] = cvt_pk_bf16(ka0 * eba0, ka1 * eba1); ok1[ep] = cvt_pk_bf16(kb0 * ebb0, kb1 * ebb1); \
        __builtin_amdgcn_sched_barrier(0); } while (0)
    HG_E2_EP(0); HG_E2_EP(1); HG_E2_EP(2); HG_E2_EP(3);
#undef HG_E2_EP
#undef HG_QB
    const int pt0 = prow(t0);
    *(LAS u32x4*)(lds + OFF_QT + t0 * QPITCH + 16 * oc) = oq0; *(LAS u32x4*)(lds + OFF_QT + (t0 + 1) * QPITCH + 16 * oc) = oq1;
    *(LAS u32x4*)(lds + OFF_KT + pt0 * PITCH + 16 * oc) = ok0; *(LAS u32x4*)(lds + OFF_KT + (pt0 + 1) * PITCH + 16 * oc) = ok1;
}
__device__ __forceinline__ void hg_stash(const HgRegs& RN, HgG& R, const int cn, LAS unsigned char* lds, const int tid, const int oc, const int t0) {
    const int pt0 = prow(t0), vv = (cn & 1) ? OFF_VV2 : OFF_VV;
    R.ga = RN.ga; R.gb = RN.gb;
    *(LAS u32x4*)(lds + vv + pt0 * PITCH + 16 * oc) = RN.va; *(LAS u32x4*)(lds + vv + (pt0 + 1) * PITCH + 16 * oc) = RN.vb;
    *(LAS u32x4*)(lds + OFF_QST + tid * 32) = RN.qa; *(LAS u32x4*)(lds + OFF_QST + tid * 32 + 16) = RN.qb;
}
template <int ABL>
__device__ __forceinline__ void hg_chunk(const int c, HgG& R, f32x4 (&St)[8], const int b, const int h, const int dir, unsigned short* G, const unsigned short* I, const unsigned short* QH, unsigned short* scratch, LAS unsigned char* lds,
                                         const int w, const int lane_in) {
    const bool lat = c >= LC / 64, more = c + 1 < S / 64;
    int lane = lane_in; asm volatile("" : "+v"(lane));
    int l15 = lane & 15, g = lane >> 4, q4 = l15 >> 2, p4 = lane & 3, oc = lane >> 2, lg = lane & 3, t0 = 2 * (4 * w + lg), tid = w * 64 + lane;
    HgRegs RN;
    if (c + 2 < S / 64) hg_prefetch<ABL>(RN, c + 2, dir, t0, oc, G, I, QH);
    float ex[8];
    if (more && w < 4) hg_e1(R, ex, lds, w, oc, lg);
    f32x4 o[4];
    const int trb = ((g >> 1) * 16 + (g & 1) * 4 + q4) * PITCH;
    if (lat) {
#pragma unroll 1
        for (int n = w; n < 10; n += 8) {
            const int ti = (n >= 6) ? 3 : (n >= 3) ? 2 : (n >= 1) ? 1 : 0, sj = n - (ti * (ti + 1)) / 2;
            bf16x8 ka[4], qb[4];
#pragma unroll
            for (int ks = 0; ks < 4; ++ks) { ka[ks] = *(const LAS bf16x8*)(lds + OFF_KT + (16 * sj + prow(l15)) * PITCH + (32 * ks + 8 * g) * 2); qb[ks] = *(const LAS bf16x8*)(lds + OFF_QT + (16 * ti + l15) * QPITCH + (32 * ks + 8 * g) * 2); }
            f32x4 a = (f32x4){0.f, 0.f, 0.f, 0.f};
#pragma unroll
            for (int ks = 0; ks < 4; ++ks) a = __builtin_amdgcn_mfma_f32_16x16x32_bf16(ka[ks], qb[ks], a, 0, 0, 0);
            if (sj == ti) {
#pragma unroll
                for (int r = 0; r < 4; ++r) if (4 * g + r > l15) a[r] = 0.f; }
            u32x2 pw; pw.x = cvt_pk_bf16(a[0], a[1]); pw.y = cvt_pk_bf16(a[2], a[3]);
            *(LAS u32x2*)(lds + OFF_ASC + (16 * ti + l15) * APITCH + (16 * sj + 4 * g) * 2) = pw;
        }
#define HG_LOADA(ks_, dst) do { _Pragma("unroll") for (int ti = 0; ti < 4; ++ti) { \
            const u32x2 alo_ = *(const LAS u32x2*)(lds + OFF_QT + (16 * ti + l15) * QPITCH + (32 * (ks_) + 4 * g) * 2), ahi_ = *(const LAS u32x2*)(lds + OFF_QT + (16 * ti + l15) * QPITCH + (32 * (ks_) + 16 + 4 * g) * 2); \
            dst[ti] = (u32x4){alo_.x, alo_.y, ahi_.x, ahi_.y}; } } while (0)
#pragma unroll
        for (int ks = 0; ks < 4; ++ks) {
            const f32x4 ca = *(const LAS f32x4*)(lds + OFF_C1 + (32 * ks + 4 * g) * 4), cb = *(const LAS f32x4*)(lds + OFF_C1 + (32 * ks + 16 + 4 * g) * 4);
            u32x4 aw[4];
            HG_LOADA(ks, aw);
            const f32x4 sa = St[2 * ks] * ca, sb = St[2 * ks + 1] * cb;
            u32x4 bw; bw.x = cvt_pk_bf16(sa[0], sa[1]); bw.y = cvt_pk_bf16(sa[2], sa[3]); bw.z = cvt_pk_bf16(sb[0], sb[1]); bw.w = cvt_pk_bf16(sb[2], sb[3]);
            const bf16x8 bs = __builtin_bit_cast(bf16x8, bw);
#pragma unroll
            for (int ti = 0; ti < 4; ++ti) o[ti] = __builtin_amdgcn_mfma_f32_16x16x32_bf16(__builtin_bit_cast(bf16x8, aw[ti]), bs, ks == 0 ? (f32x4){0.f, 0.f, 0.f, 0.f} : o[ti], 0, 0, 0);
        }
#undef HG_LOADA
    }
    bf16x8 vf[2];
#pragma unroll
    for (int kk = 0; kk < 2; ++kk) vf[kk] = trpair(lds + ((c & 1) ? OFF_VV2 : OFF_VV) + 32 * kk * PITCH + trb + (16 * w + 4 * p4) * 2);
#pragma unroll
    for (int blk = 0; blk < 8; ++blk) {
        f32x4 tt = (f32x4){0.f, 0.f, 0.f, 0.f};
#pragma unroll
        for (int kk = 0; kk < 2; ++kk) { const bf16x8 ka = trpair(lds + OFF_KT + 32 * kk * PITCH + trb + (16 * blk + 4 * p4) * 2);
            tt = __builtin_amdgcn_mfma_f32_16x16x32_bf16(ka, vf[kk], tt, 0, 0, 0); }
        const f32x4 dd = *(const LAS f32x4*)(lds + OFF_D + (16 * blk + 4 * g) * 4), cc = *(const LAS f32x4*)(lds + OFF_C2 + (16 * blk + 4 * g) * 4);
        St[blk] = dd * St[blk] + cc * tt;
        if (blk == 3) __builtin_amdgcn_sched_barrier(0);
    }
    if (more && w >= 4) hg_e1(R, ex, lds, w, oc, lg);
    asm volatile("s_waitcnt lgkmcnt(0)\n\ts_barrier" : "+v"(St[0]), "+v"(St[1]), "+v"(St[2]), "+v"(St[3]), "+v"(St[4]), "+v"(St[5]), "+v"(St[6]), "+v"(St[7]) :: "memory");
    lane = lane_in; asm volatile("" : "+v"(lane));
    l15 = lane & 15; g = lane >> 4; q4 = l15 >> 2; p4 = lane & 3; oc = lane >> 2; lg = lane & 3; t0 = 2 * (4 * w + lg); tid = w * 64 + lane;
    const int vrow = tid >> 3, vpc = tid & 7;
    if (lat) {
        bf16x8 af[6];
        af[0] = *(const LAS bf16x8*)(lds + OFF_ASC + (l15) * APITCH + (8 * g) * 2); af[1] = *(const LAS bf16x8*)(lds + OFF_ASC + (16 + l15) * APITCH + (8 * g) * 2);
        af[2] = *(const LAS bf16x8*)(lds + OFF_ASC + (32 + l15) * APITCH + (8 * g) * 2); af[3] = *(const LAS bf16x8*)(lds + OFF_ASC + (32 + l15) * APITCH + (32 + 8 * g) * 2);
        af[4] = *(const LAS bf16x8*)(lds + OFF_ASC + (48 + l15) * APITCH + (8 * g) * 2); af[5] = *(const LAS bf16x8*)(lds + OFF_ASC + (48 + l15) * APITCH + (32 + 8 * g) * 2);
        o[0] = __builtin_amdgcn_mfma_f32_16x16x32_bf16(af[0], vf[0], o[0], 0, 0, 0); o[1] = __builtin_amdgcn_mfma_f32_16x16x32_bf16(af[1], vf[0], o[1], 0, 0, 0);
        o[2] = __builtin_amdgcn_mfma_f32_16x16x32_bf16(af[2], vf[0], o[2], 0, 0, 0); o[3] = __builtin_amdgcn_mfma_f32_16x16x32_bf16(af[4], vf[0], o[3], 0, 0, 0);
        o[2] = __builtin_amdgcn_mfma_f32_16x16x32_bf16(af[3], vf[1], o[2], 0, 0, 0); o[3] = __builtin_amdgcn_mfma_f32_16x16x32_bf16(af[5], vf[1], o[3], 0, 0, 0);
        __builtin_amdgcn_sched_barrier(0);
    }
    if (more) hg_e2(R, ex, lds, tid, w, oc, lg, t0);
    if (lat) {
#pragma unroll
        for (int ti = 0; ti < 4; ++ti)
#pragma unroll
            for (int r = 0; r < 4; ++r) *(LAS unsigned short*)(lds + OFF_OB + (16 * ti + 4 * g + r) * PITCH + (16 * w + l15) * 2) = (unsigned short)f2bf(o[ti][r]);
    }
    HG_BAR();
    if (c + 2 < S / 64) hg_stash(RN, R, c + 2, lds, tid, oc, t0);
    if (lat) { const int r_ = HG_ROW(c * 64 + vrow); u32x4* d_ = scratch ? (u32x4*)(scratch + ((size_t)b * T + (r_ - LC)) * 1024 + h * 128 + vpc * 16) : (u32x4*)(G + (size_t)r_ * 128 + vpc * 16);
        __builtin_nontemporal_store(*(const LAS u32x4*)(lds + OFF_OB + vrow * PITCH + vpc * 32), d_); __builtin_nontemporal_store(*(const LAS u32x4*)(lds + OFF_OB + vrow * PITCH + vpc * 32 + 16), d_ + 1); }
}
template <int ABL>
__device__ __forceinline__ void hgrn_unit(const int b, const int h, const int dir, unsigned char* ws, LAS unsigned char* lds, unsigned short* scratch) {
    int tid_ = threadIdx.x; asm volatile("" : "+v"(tid_));
    const int tid = tid_, w = __builtin_amdgcn_readfirstlane(tid >> 6), lane = tid & 63, l15 = lane & 15, g = lane >> 4, q4 = l15 >> 2, p4 = lane & 3;
    unsigned short* G = (unsigned short*)(ws + (dir == 0 ? WS_GF : WS_GB)) + (size_t)(b * NH + h) * S * 128;
    const unsigned short* I = (const unsigned short*)(ws + WS_IALL) + (size_t)(b * NH + h) * S * 128;
    const unsigned short* QH = (const unsigned short*)(ws + WS_QH) + (size_t)(b * NH + h) * T * 128;
    f32x4 St[8];
#pragma unroll
    for (int k = 0; k < 8; ++k) St[k] = (f32x4){0.f, 0.f, 0.f, 0.f};
    { unsigned z = 0u; asm volatile("" : "+v"(z));
      for (int i = tid; i < 64 * APITCH / 16; i += 512) *(LAS u32x4*)(lds + OFF_ASC + i * 16) = (u32x4){z, z, z, z}; }
    const int oc = lane >> 2, lg = lane & 3, t0 = 2 * (4 * w + lg);
    HgRegs RA, RB;
    hg_prefetch<ABL>(RA, 0, dir, t0, oc, G, I, QH); hg_prefetch<ABL>(RB, 1, dir, t0, oc, G, I, QH);
    __syncthreads();
    HgG R;
    hg_stash(RA, R, 0, lds, tid, oc, t0);
    { float ex0[8]; hg_e1(R, ex0, lds, w, oc, lg); HG_BAR(); hg_e2(R, ex0, lds, tid, w, oc, lg, t0); HG_BAR(); }
    hg_stash(RB, R, 1, lds, tid, oc, t0);
#pragma unroll 1
    for (int c = 0; c < S / 64; ++c) hg_chunk<ABL>(c, R, St, b, h, dir, G, I, QH, scratch, lds, w, lane);
    __syncthreads();
}
#undef HG_ROW
}


struct SchedZ {
    int G, c; const char* H; const char* W;
    __device__ __forceinline__ bool next(int i, pg8::Unit& u) const {
        const int L = i * G + c; if (L >= 128 * 12) return false;
        pg8::tile_map(L, 128, 12, u.pm, u.pn); if (u.pn >= 8) u.pn += 4;
        u.kind = 0; u.A = H + (size_t)u.pm * (256 * 1024 * 2); u.B = W + (size_t)u.pn * (256 * 1024 * 2); return true;
    }
};
struct EpiZ {
    static constexpr bool PERM = true, MID = false, STORES16 = true;
    unsigned char* ws; const float* hgain; LAS unsigned char* lds; unsigned char* outb;
    __device__ __forceinline__ void operator()(const f32x4 (&acc)[2][2][4][2], const pg8::Unit& u, int wr, int wc, int fr, int fq) const {
        const int grp = u.pn >> 2, cg0 = (u.pn & 3) * 256 + wc * 32 + 8 * fq;
        bf16_t* dst = (grp == 2 ? (bf16_t*)(outb + OUT_GA) : (bf16_t*)(ws + (grp < 2 ? ya_panel_off(u.pm) : WS_GH))) + (grp == 1 ? 1024 : 0); const int dp = grp < 2 ? 2048 : 1024;
        const int row0 = u.pm * 256 + wr * 64 + fr, drow0 = grp < 2 ? wr * 64 + fr : row0;
        if (grp == 1) {
            const size_t hb = ((size_t)((u.pm >> 4) * NH + (u.pn & 3) * 2) * S + LC + (u.pm & 15) * 256 + wr * 64 + fr) * 128 + wc * 32 + 8 * fq;
            const bf16_t* of = (const bf16_t*)(ws + WS_GF) + hb; const bf16_t* ob = (const bf16_t*)(ws + WS_GB) + hb;
            LAS float* xs = (LAS float*)(lds + XS_OFF);
#pragma unroll
            for (int ai = 0; ai < 2; ++ai)
#pragma unroll
                for (int m = 0; m < 4; ++m)
#pragma unroll
                    for (int bj = 0; bj < 2; ++bj) { const size_t o_ = (size_t)(ai * 128 + m * 16) * 128 + (size_t)bj * S * 128;
                        const u32x4 a = *(const u32x4*)(of + o_), b = *(const u32x4*)(ob + o_);
                        const float s0 = bflo(a.x) + bflo(b.x), s1 = bfhi(a.x) + bfhi(b.x), s2 = bflo(a.y) + bflo(b.y), s3 = bfhi(a.y) + bfhi(b.y), s4 = bflo(a.z) + bflo(b.z), s5 = bfhi(a.z) + bfhi(b.z), s6 = bflo(a.w) + bflo(b.w), s7 = bfhi(a.w) + bfhi(b.w);
                        float ss = (s0 * s0 + s1 * s1) + (s2 * s2 + s3 * s3) + (s4 * s4 + s5 * s5) + (s6 * s6 + s7 * s7);
                        ss += __shfl_xor(ss, 16); ss += __shfl_xor(ss, 32);
                        if (fq == 0) xs[((ai * 128 + wr * 64 + m * 16 + fr) * 2 + bj) * 4 + wc] = ss; }
            asm volatile("s_waitcnt lgkmcnt(0)" ::: "memory"); __builtin_amdgcn_s_barrier(); asm volatile("" ::: "memory");
            const f32x4 g0 = *(const f32x4*)(hgain + wc * 32 + 8 * fq), g1 = *(const f32x4*)(hgain + wc * 32 + 8 * fq + 4);
#pragma unroll
            for (int ai = 0; ai < 2; ++ai)
#pragma unroll
                for (int m = 0; m < 4; ++m) { const size_t off = (size_t)(drow0 + ai * 128 + m * 16) * dp + cg0;
#pragma unroll
                    for (int bj = 0; bj < 2; ++bj) { const size_t o_ = (size_t)(ai * 128 + m * 16) * 128 + (size_t)bj * S * 128;
                        const f32x4 p = *(const LAS f32x4*)(xs + ((ai * 128 + wr * 64 + m * 16 + fr) * 2 + bj) * 4);
                        const float rstd = __builtin_amdgcn_rsqf(((p[0] + p[1]) + (p[2] + p[3])) * (1.f / 128.f) + EPS);
                        const u32x4 a = *(const u32x4*)(of + o_), b = *(const u32x4*)(ob + o_);
                        const f32x4 v0 = acc[ai][bj][m][0], v1 = acc[ai][bj][m][1];
                        const float y0 = (bflo(a.x) + bflo(b.x)) * rstd * g0[0] * siluf_(v0[0]), y1 = (bfhi(a.x) + bfhi(b.x)) * rstd * g0[1] * siluf_(v0[1]);
                        const float y2 = (bflo(a.y) + bflo(b.y)) * rstd * g0[2] * siluf_(v0[2]), y3 = (bfhi(a.y) + bfhi(b.y)) * rstd * g0[3] * siluf_(v0[3]);
                        const float y4 = (bflo(a.z) + bflo(b.z)) * rstd * g1[0] * siluf_(v1[0]), y5 = (bfhi(a.z) + bfhi(b.z)) * rstd * g1[1] * siluf_(v1[1]);
                        const float y6 = (bflo(a.w) + bflo(b.w)) * rstd * g1[2] * siluf_(v1[2]), y7 = (bfhi(a.w) + bfhi(b.w)) * rstd * g1[3] * siluf_(v1[3]);
                        u32x4 w; w.x = cvt_pk_bf16(y0, y1); w.y = cvt_pk_bf16(y2, y3); w.z = cvt_pk_bf16(y4, y5); w.w = cvt_pk_bf16(y6, y7);
                        *(u32x4*)(dst + off + bj * 128) = w; } }
            return;
        }
        const bf16_t* src = (const bf16_t*)(ws + WS_Q);
#pragma unroll
        for (int ai = 0; ai < 2; ++ai)
#pragma unroll
            for (int m = 0; m < 4; ++m) { const size_t ioff = (size_t)(row0 + ai * 128 + m * 16) * 1024 + cg0, off = (size_t)(drow0 + ai * 128 + m * 16) * dp + cg0;
#pragma unroll
                for (int bj = 0; bj < 2; ++bj) { f32x4 v0 = acc[ai][bj][m][0], v1 = acc[ai][bj][m][1];
                    if (grp == 0) { const u32x4 s = *(const u32x4*)(src + ioff + bj * 128);
                        v0[0] = siluf_(v0[0]) * bflo(s.x); v0[1] = siluf_(v0[1]) * bfhi(s.x); v0[2] = siluf_(v0[2]) * bflo(s.y); v0[3] = siluf_(v0[3]) * bfhi(s.y);
                        v1[0] = siluf_(v1[0]) * bflo(s.z); v1[1] = siluf_(v1[1]) * bfhi(s.z); v1[2] = siluf_(v1[2]) * bflo(s.w); v1[3] = siluf_(v1[3]) * bfhi(s.w);
                    } else {
#pragma unroll
                        for (int e = 0; e < 4; ++e) { v0[e] = sigmoidf_(v0[e]); v1[e] = sigmoidf_(v1[e]); }
                    }
                    u32x4 w; w.x = cvt_pk_bf16_t(v0[0], v0[1]); w.y = cvt_pk_bf16_t(v0[2], v0[3]); w.z = cvt_pk_bf16_t(v1[0], v1[1]); w.w = cvt_pk_bf16_t(v1[2], v1[3]);
                    *(u32x4*)(dst + off + bj * 128) = w; } }
    }
};
struct SchedOne {
    int pm, pn; const char* H; const char* W;
    __device__ __forceinline__ bool next(int i, pg8::Unit& u) const {
        if (i > 0) return false;
        u.pm = pm; u.pn = pn + i; u.kind = 0; u.A = H + (size_t)pm * (256 * 1024 * 2); u.B = W + (size_t)(pn + i) * (256 * 1024 * 2); return true;
    }
};
struct SchedM {
    int G, c; const char* Y; const char* WB;
    __device__ __forceinline__ bool next(int i, pg8::Unit& u) const {
        const int tile = i * G + c; if (tile >= 128 * 4) return false;
        pg8::tile_map(tile, 128, 4, u.pm, u.pn); u.kind = 0;
        u.A = Y + ya_panel_off(u.pm); u.B = WB + (size_t)u.pn * (256 * 2048 * 2); return true;
    }
};
struct EpiM {
    static constexpr bool PERM = true, MID = true, STORES16 = true;
    unsigned char* ws; unsigned char* outb;
    __device__ __forceinline__ void mid(f32x4 (&acc)[2][2][4][2], const pg8::Unit& u, int wr, int wc, int fr, int fq) const {
        const size_t ubo = ((size_t)(u.pm * 256 + wr * 64) * 1024 + u.pn * 256 + wc * 32) * 2; unsigned loff = (unsigned)(fr * 1024 + 8 * fq) * 2u;
        asm volatile("" : "+v"(loff));
        const unsigned char* ga = outb + OUT_GA + ubo; const unsigned char* gh = ws + WS_GH + ubo;
#pragma unroll
        for (int ai = 0; ai < 2; ++ai)
#pragma unroll
            for (int m = 0; m < 4; ++m) { const unsigned char* gar = ga + (size_t)((ai * 128 + m * 16) * 2048); const unsigned char* ghr = gh + (size_t)((ai * 128 + m * 16) * 2048);
#pragma unroll
                for (int bj = 0; bj < 2; ++bj) { const u32x4 a = *(const u32x4*)(gar + bj * 256 + loff), h = *(const u32x4*)(ghr + bj * 256 + loff);
                    f32x4& v0 = acc[ai][bj][m][0]; f32x4& v1 = acc[ai][bj][m][1];
                    v0[0] *= bflo(a.x) * __builtin_amdgcn_rcpf(bflo(h.x)); v0[1] *= bfhi(a.x) * __builtin_amdgcn_rcpf(bfhi(h.x)); v0[2] *= bflo(a.y) * __builtin_amdgcn_rcpf(bflo(h.y)); v0[3] *= bfhi(a.y) * __builtin_amdgcn_rcpf(bfhi(h.y));
                    v1[0] *= bflo(a.z) * __builtin_amdgcn_rcpf(bflo(h.z)); v1[1] *= bfhi(a.z) * __builtin_amdgcn_rcpf(bfhi(h.z)); v1[2] *= bflo(a.w) * __builtin_amdgcn_rcpf(bflo(h.w)); v1[3] *= bfhi(a.w) * __builtin_amdgcn_rcpf(bfhi(h.w)); }
                if (m == 3) asm volatile("" ::: "memory"); }
    }
    __device__ __forceinline__ void operator()(const f32x4 (&acc)[2][2][4][2], const pg8::Unit& u, int wr, int wc, int fr, int fq) const {
        const size_t ubo = ((size_t)(u.pm * 256 + wr * 64) * 1024 + u.pn * 256 + wc * 32) * 2; unsigned loff = (unsigned)(fr * 1024 + 8 * fq) * 2u;
        asm volatile("" : "+v"(loff));
        const unsigned char* gate = ws + WS_GH + ubo; unsigned char* mm = ws + mm_panel_off(u.pm) + ((size_t)(wr * 64) * 1024 + u.pn * 256 + wc * 32) * 2;
#pragma unroll
        for (int ai = 0; ai < 2; ++ai)
#pragma unroll
            for (int m = 0; m < 4; ++m) { const unsigned char* gr = gate + (size_t)((ai * 128 + m * 16) * 2048); unsigned char* mr = mm + (size_t)((ai * 128 + m * 16) * 2048);
#pragma unroll
                for (int bj = 0; bj < 2; ++bj) { f32x4 v0 = acc[ai][bj][m][0], v1 = acc[ai][bj][m][1]; const u32x4 g = *(const u32x4*)(gr + bj * 256 + loff);
                    v0[0] *= bflo(g.x); v0[1] *= bfhi(g.x); v0[2] *= bflo(g.y); v0[3] *= bfhi(g.y); v1[0] *= bflo(g.z); v1[1] *= bfhi(g.z); v1[2] *= bflo(g.w); v1[3] *= bfhi(g.w);
                    u32x4 w; w.x = cvt_pk_bf16(v0[0], v0[1]); w.y = cvt_pk_bf16(v0[2], v0[3]); w.z = cvt_pk_bf16(v1[0], v1[1]); w.w = cvt_pk_bf16(v1[2], v1[3]);
                    *(u32x4*)(mr + bj * 256 + loff) = w; } }
    }
};
struct SchedO {
    int G, c; const char* MMp; const char* W;
    __device__ __forceinline__ bool next(int i, pg8::Unit& u) const {
        const int L = i * G + c; if (L >= 128 * 4) return false;
        pg8::tile_map(L, 128, 4, u.pm, u.pn); u.kind = 0; u.A = MMp + mm_panel_off(u.pm); u.B = W + (size_t)u.pn * (256 * 1024 * 2); return true;
    }
};
struct EpiOut {
    static constexpr bool PERM = false, MID = false, STORES16 = true;
    const float* x; float* out; const float* par;
    __device__ __forceinline__ void operator()(const f32x4 (&acc)[2][2][4][2], const pg8::Unit& u, int wr, int wc, int fr, int fq) const {
        const int row0 = u.pm * 256 + wr * 64 + fr, col0 = u.pn * 256 + wc * 32 + 4 * fq;
        const float* gp = par + PAR_MOD + (u.pm >> 4) * 3072 + 2048 + col0;
        f32x4 gv[2][2];
#pragma unroll
        for (int bj = 0; bj < 2; ++bj)
#pragma unroll
            for (int n = 0; n < 2; ++n) gv[bj][n] = *(const f32x4*)(gp + bj * 128 + n * 16);
#pragma unroll
        for (int ai = 0; ai < 2; ++ai)
#pragma unroll
            for (int m = 0; m < 4; ++m) { const size_t off = (size_t)(row0 + ai * 128 + m * 16) * 1024 + col0;
#pragma unroll
                for (int bj = 0; bj < 2; ++bj)
#pragma unroll
                    for (int n = 0; n < 2; ++n) { const f32x4 xv = *(const f32x4*)(x + off + bj * 128 + n * 16); *(f32x4*)(out + off + bj * 128 + n * 16) = xv + gv[bj][n] * acc[ai][bj][m][n]; } }
    }
};

constexpr int CW_QUEUE = 8192;
__device__ __forceinline__ void mix_phase(Frame& F, volatile LAS unsigned* MISC) {
    const float lam = F.par[PAR_SCAL], shift2 = F.par[PAR_SCAL + 1];
    const int x = F.xq, nq = (F.G == 256) ? 8 : 1;
    unsigned* ctr = (unsigned*)(F.ws + WS_CTL) + CW_QUEUE + 64 * x;
    const int n_h = 128 / nq, n_a = 2048 / nq, n_g = 512 / nq;
    for (;;) {
        if (F.tid == 0) MISC[16] = __hip_atomic_fetch_add(ctr, 1u, __ATOMIC_RELAXED, __HIP_MEMORY_SCOPE_AGENT);
        __syncthreads();
        const int item = __builtin_amdgcn_readfirstlane((int)MISC[16]);
        __syncthreads();
        if (item >= n_h + n_a + n_g) break;
        if (item < n_h) { const int u = x * n_h + item;
#if defined(REP_HG)
            hg::hgrn_unit<REP_HG - 1>(u >> 4, (u >> 1) & 7, u & 1, F.ws, F.lds, (unsigned short*)(F.outb + OUT_YH));
#endif
            hg::hgrn_unit<0>(u >> 4, (u >> 1) & 7, u & 1, F.ws, F.lds, nullptr); }
        else if (item >= n_h + n_a) { const int gi = x * n_g + (item - n_h - n_a);
            SchedOne Sc{gi >> 2, 8 + (gi & 3), (const char*)(F.outb + OUT_H), (const char*)(F.ws + WS_WIN + (size_t)7168 * 1024 * 2)};
            EpiZ E{F.ws, F.in[IN_HG], F.lds, F.outb};
            pg8::gemm_phase<EpiZ, SchedOne, true, true>(F.lds, D, Sc, E); }
        else { const int a = item - n_h, bh = x * (n_a >> 5) + (a >> 5), qb = a & 31, b = bh >> 3, h = bh & 7;
            const size_t qoff = ((size_t)b * T + (size_t)qb * 128) * 1024 + h * 128;
            const bf16_t* Qb = (const bf16_t*)(F.ws + WS_Q) + qoff; bf16_t* Ob = (bf16_t*)(F.ws + WS_Q) + qoff;
            const bf16_t* Kh = (const bf16_t*)(F.ws + WS_KALL) + (size_t)bh * S * 128;
            const bf16_t* Vh = (const bf16_t*)(F.ws + WS_VALL) + (size_t)bh * S * 128;
#if defined(REP_ATT)
            attn::attn_unit<REP_ATT - 1>(Qb, (bf16_t*)(F.outb + OUT_YH) + qoff, Kh, Vh, lam, shift2, F.in[IN_SUBG], (char*)F.ldsg, F.lds);
#endif
            attn::attn_unit<0>(Qb, Ob, Kh, Vh, lam, shift2, F.in[IN_SUBG], (char*)F.ldsg, F.lds); }
    }
}

constexpr int N_PHASES = 9;
__global__ void __launch_bounds__(512, 2) mega_fwd(Args args) {
    extern __shared__ __attribute__((aligned(16))) unsigned char lds[];
    Frame F;
    F.lds = (LAS unsigned char*)lds; F.ldsg = lds;
    F.tid = threadIdx.x; F.lane = F.tid & 63; F.wave = __builtin_amdgcn_readfirstlane(F.tid >> 6);
    F.G = gridDim.x; { const int bx = blockIdx.x; F.vcu = (F.G % 8 == 0) ? (bx % 8) * (F.G / 8) + bx / 8 : bx; }
#pragma unroll
    for (int i = 0; i < 21; ++i) F.in[i] = args.in[i];
    F.ws = args.ws; F.outb = (unsigned char*)args.out; F.par = (float*)(args.ws + WS_PAR);
    volatile LAS unsigned* MISC = (volatile LAS unsigned*)(F.lds + MISC_OFF);
    for (int u = F.tid; u < (LDS_BYTES - LDSCTL_OFF) / 4; u += 512) ((LAS unsigned*)(F.lds + LDSCTL_OFF))[u] = 0u;
    __syncthreads();
    XcdBarrier bar; bar.bar = (unsigned*)(args.ws + WS_CTL) + CW_BAR; bar.x = 0; bar.st = nullptr;
    if (MK_ONE_LAUNCH) bar = xcd_barrier_post((unsigned*)(args.ws + WS_CTL) + CW_BAR, MISC + 8);
    const int lo = args.ph_lo, hi = args.ph_hi;
#ifndef REPEAT_MASK
#define REPEAT_MASK 0
#endif
#ifndef PH_MASK
#define PH_MASK 0x1ff
#endif
#define IN(k) (((PH_MASK >> (k)) & 1) && lo <= (k) && (k) < hi)
#define REP(k) (((REPEAT_MASK >> (k)) & 1) ? 2 : 1)
#define SEAM(k) do { if (IN(k) && IN((k) + 1)) xcd_barrier(bar); } while (0)
#define SEAM_XCD(k) do { if (IN(k) && IN((k) + 1)) { if (F.xl) xcd_local_barrier(bar); else xcd_barrier(bar); } } while (0)
    F.cidx = (int)blockIdx.x; F.xq = (F.G == 256) ? (F.vcu >> 5) : 0; F.xl = 0;
    if (IN(0)) for (int rep_ = 0; rep_ < REP(0); ++rep_) { p0a(F); p0_weights(F); __syncthreads(); } SEAM(0);
    if (MK_ONE_LAUNCH && IN(0) && IN(1)) { const unsigned e8 = MISC[11], rk = MISC[10];
        if (e8 == 1u) { F.xl = 1; F.xq = (int)bar.x; F.cidx = (int)(rk * 8u + bar.x); } }
    if (IN(1)) for (int rep_ = 0; rep_ < REP(1); ++rep_) { p0b(F); __syncthreads(); } SEAM_XCD(1);
#if defined(REP_P1)
    if (IN(2)) { SchedIn Sc{F.G, (int)blockIdx.x, (const char*)(F.outb + OUT_H), (const char*)(F.ws + WS_HC), (const char*)(F.ws + WS_WIN)};
        EpiProbe<REP_P1> E{F.outb + OUT_YH};
        pg8::gemm_phase<EpiProbe<REP_P1>, SchedIn, true, true>(F.lds, D, Sc, E); }
#endif
    if (IN(2)) for (int rep_ = 0; rep_ < REP(2); ++rep_) {
        SchedIn Sc{F.G, F.cidx, (const char*)(F.outb + OUT_H), (const char*)(F.ws + WS_HC), (const char*)(F.ws + WS_WIN)};
        EpiIn E{F.ws, F.par, F.in[IN_KG], F.in[IN_QG]};
        pg8::gemm_phase<EpiIn, SchedIn, true, true>(F.lds, D, Sc, E);
    } SEAM_XCD(2);
    if (IN(4)) { mix_phase(F, MISC); } SEAM_XCD(4);
    if (IN(6)) for (int rep_ = 0; rep_ < REP(6); ++rep_) {
        SchedZ Sc{F.G, F.cidx, (const char*)(F.outb + OUT_H), (const char*)(F.ws + WS_WIN + (size_t)7168 * 1024 * 2)};
        EpiZ E{F.ws, F.in[IN_HG], F.lds, F.outb};
        pg8::gemm_phase<EpiZ, SchedZ, true, true>(F.lds, D, Sc, E);
    } SEAM_XCD(6);
    if (IN(7)) for (int rep_ = 0; rep_ < REP(7); ++rep_) {
        SchedM Sc{F.G, F.cidx, (const char*)F.ws, (const char*)(F.ws + WS_WBA)};
        EpiM E{F.ws, F.outb};
        pg8::gemm_phase<EpiM, SchedM, true, true>(F.lds, 2 * D, Sc, E);
    }
    if (IN(7) && IN(8)) { if (F.xl) { const unsigned p = (unsigned)((2 * F.xq) & 7); xcd_local_barrier<true>(bar, p, p + 1u); } else xcd_barrier(bar); }
    if (IN(8)) for (int rep_ = 0; rep_ < REP(8); ++rep_) {
        SchedO Sc{F.G, F.cidx, (const char*)F.ws, (const char*)(F.ws + WS_WO)};
        EpiOut E{F.in[IN_X], args.out, F.par};
        pg8::gemm_phase<EpiOut, SchedO, true, true>(F.lds, D, Sc, E);
    }
#undef IN
#undef SEAM
#undef SEAM_XCD
}

extern "C" void kernel_launch(void* const* d_in, const int* in_sizes, int n_in, void* d_out, int out_size, void* d_ws, size_t ws_size, hipStream_t stream) {
    static int grid = 0;
    if (grid == 0) {
        if (n_in != 21 || in_sizes[0] != M * D || out_size != M * D || ws_size < WS_END) { fprintf(stderr, "kernel_launch: unexpected shapes: n_in %d in0 %d out %d ws %zu (need %zu)\n", n_in, n_in > 0 ? in_sizes[0] : -1, out_size, ws_size, (size_t)WS_END); grid = -1; return; }
        int dev = 0, cus = 0, per_cu = 0;
        if (hipGetDevice(&dev) != hipSuccess || hipDeviceGetAttribute(&cus, hipDeviceAttributeMultiprocessorCount, dev) != hipSuccess) { grid = -1; return; }
        if (hipFuncSetAttribute((const void*)mega_fwd, hipFuncAttributeMaxDynamicSharedMemorySize, LDS_BYTES) != hipSuccess) { fprintf(stderr, "kernel_launch: hipFuncSetAttribute failed\n"); grid = -1; return; }
        if (hipOccupancyMaxActiveBlocksPerMultiprocessor(&per_cu, (const void*)mega_fwd, 512, LDS_BYTES) != hipSuccess || per_cu < 1) fprintf(stderr, "kernel_launch: occupancy query reports %d\n", per_cu);
        (void)hipGetLastError();
        grid = cus;
        if (grid != 256) fprintf(stderr, "kernel_launch: %d CUs; this build assumes 256\n", grid);
    }
    if (grid < 0) return;
    (void)hipMemsetAsync((char*)d_ws + WS_CTL, 0, CTL_ZERO_BYTES, stream);
    Args a{};
    for (int i = 0; i < 21; ++i) a.in[i] = (const float*)d_in[i];
    a.out = (float*)d_out; a.ws = (unsigned char*)d_ws;
    if (MK_ONE_LAUNCH) { a.ph_lo = 0; a.ph_hi = N_PHASES; hipLaunchKernelGGL(mega_fwd, dim3(grid), dim3(512), LDS_BYTES, stream, a); }
    else for (int p = 0; p < N_PHASES; ++p) { a.ph_lo = p; a.ph_hi = p + 1; hipLaunchKernelGGL(mega_fwd, dim3(grid), dim3(512), LDS_BYTES, stream, a); }
    const hipError_t le = hipPeekAtLastError();
    if (le != hipSuccess) fprintf(stderr, "kernel_launch: launch failed: %s\n", hipGetErrorName(le));
}
```
